# Optimizing an MI355X kernel written in HIP

```python
import math
import jax, jax.numpy as jnp
from jax import lax
import numpy as np

D_MODEL = 1024
BATCH = 16
SEQ = 256
DEPTH = 1
DEC_BATCH = 8
DEC_SEQ = 2048
PAST_LEN = 512

GRID_W = 64
N_HEADS_A = 4
HEAD_K = 128
HEAD_V = 128
D_A = N_HEADS_A * HEAD_V
CONV_K = 5
CHUNK = 64
N_GROUPS_B = 4
POOL_WINDOWS = (2, 4, 8, 16)
D_B = 512
GROUP_B = D_B // N_GROUPS_B
D_FF = 2816
N_MOD = 6
EPS = 1e-6
D_IN = 4 * D_A + 4 * N_HEADS_A + D_B + 2 * D_MODEL

kernel_name = "hybrid_deltanet_pool_diffusion_step"


def _rmsnorm(x, g):
    xf = x.astype(jnp.float32)
    y = xf * lax.rsqrt(jnp.mean(xf * xf, axis=-1, keepdims=True) + EPS)
    return (y * g.astype(jnp.float32)).astype(x.dtype)


def _l2norm(x):
    xf = x.astype(jnp.float32)
    return xf * lax.rsqrt(jnp.sum(xf * xf, axis=-1, keepdims=True) + EPS)


def _short_conv(u, w):
    y = lax.conv_general_dilated(u, w[:, None, :].astype(u.dtype), window_strides=(1,),
                                 padding=[(CONV_K // 2, CONV_K // 2)],
                                 dimension_numbers=('NWC', 'WIO', 'NWC'),
                                 feature_group_count=u.shape[-1])
    return jax.nn.silu(y)


def _split_cols(proj):
    sizes = (3 * D_A, D_A, 2 * N_HEADS_A, 2 * N_HEADS_A, D_B, D_MODEL, D_MODEL)
    pts, acc = [], 0
    for s in sizes[:-1]:
        acc += s
        pts.append(acc)
    return jnp.split(proj, pts, axis=-1)


def _gated_delta_chunked(q, k, v, g, beta, s0):
    B, T, H, K = q.shape
    V = v.shape[-1]
    N = T // CHUNK

    def to_chunks(a):
        a = a.reshape((B, N, CHUNK) + a.shape[2:])
        return jnp.moveaxis(a, (1, 2), (0, 3))

    qc = to_chunks(q) * (K ** -0.5)
    kc = to_chunks(k)
    vc = to_chunks(v)
    bc = to_chunks(beta)
    gc = jnp.cumsum(to_chunks(g), axis=-1)
    idx = jnp.arange(CHUNK)
    causal = idx[:, None] >= idx[None, :]
    strict = idx[:, None] > idx[None, :]
    diff = gc[..., :, None] - gc[..., None, :]
    decay = jnp.where(causal, jnp.exp(jnp.where(causal, diff, 0.0)), 0.0)
    kb = kc * bc[..., None]
    lower = jnp.where(strict, jnp.einsum('nbhik,nbhjk->nbhij', kb, kc) * decay, 0.0)
    eye = jnp.eye(CHUNK, dtype=jnp.float32)
    t_inv = lax.linalg.triangular_solve(eye + lower, jnp.broadcast_to(eye, lower.shape),
                                        left_side=True, lower=True, unit_diagonal=True)
    u = jnp.einsum('nbhij,nbhjv->nbhiv', t_inv, vc * bc[..., None])
    w = jnp.einsum('nbhij,nbhjk->nbhik', t_inv, kb * jnp.exp(gc)[..., None])
    intra = jnp.where(causal, jnp.einsum('nbhik,nbhjk->nbhij', qc, kc) * decay, 0.0)
    q_dec = qc * jnp.exp(gc)[..., None]
    g_last = gc[..., -1]
    k_dec = kc * jnp.exp(g_last[..., None] - gc)[..., None]

    def step(S, inp):
        u_i, w_i, intra_i, qd_i, kd_i, gl_i = inp
        v_new = u_i - jnp.einsum('bhck,bhkv->bhcv', w_i, S)
        o_i = jnp.einsum('bhck,bhkv->bhcv', qd_i, S) + jnp.einsum('bhij,bhjv->bhiv', intra_i, v_new)
        S = S * jnp.exp(gl_i)[..., None, None] + jnp.einsum('bhck,bhcv->bhkv', kd_i, v_new)
        return S, o_i

    s_fin, o = lax.scan(step, s0, (u, w, intra, q_dec, k_dec, g_last))
    o = jnp.moveaxis(o, (0, 3), (1, 2)).reshape(B, T, H, V)
    return o, s_fin


def _delta_branch(qkv, z, a, b, s0, a_log, dt_bias, g_onorm):
    B, T, _ = qkv.shape
    q, k, v = jnp.split(qkv, 3, axis=-1)
    qh = _l2norm(q.reshape(B, T, N_HEADS_A, HEAD_K))
    kh = _l2norm(k.reshape(B, T, N_HEADS_A, HEAD_K))
    vh = v.reshape(B, T, N_HEADS_A, HEAD_V).astype(jnp.float32)
    a4 = a.reshape(B, T, 2, N_HEADS_A).astype(jnp.float32)
    b4 = b.reshape(B, T, 2, N_HEADS_A).astype(jnp.float32)
    g = -jnp.exp(a_log.astype(jnp.float32)) * jax.nn.softplus(a4 + dt_bias.astype(jnp.float32))
    beta = jax.nn.sigmoid(b4)
    s0f = s0.astype(jnp.float32)
    o_f, s_f = _gated_delta_chunked(qh, kh, vh, g[:, :, 0], beta[:, :, 0], s0f[:, 0])
    o_b, s_b = _gated_delta_chunked(qh[:, ::-1], kh[:, ::-1], vh[:, ::-1],
                                    g[:, ::-1, 1], beta[:, ::-1, 1], s0f[:, 1])
    o = o_f + o_b[:, ::-1]
    o = _rmsnorm(o, g_onorm) * jax.nn.silu(z.reshape(B, T, N_HEADS_A, HEAD_V).astype(jnp.float32))
    return o.reshape(B, T, D_A).astype(qkv.dtype), jnp.stack([s_f, s_b], axis=1)


def _window_mean(u, w, axis):
    n = u.shape[axis]
    cs = jnp.cumsum(u, axis=axis)
    cs = jnp.concatenate([jnp.zeros_like(lax.slice_in_dim(cs, 0, 1, axis=axis)), cs], axis=axis)
    t = jnp.arange(n)
    lo = jnp.clip(t - w // 2, 0, n)
    hi = jnp.clip(t + (w - w // 2), 0, n)
    total = jnp.take(cs, hi, axis=axis) - jnp.take(cs, lo, axis=axis)
    cnt_shape = [1] * u.ndim
    cnt_shape[axis] = n
    return total / (hi - lo).astype(u.dtype).reshape(cnt_shape)


def _pool_branch(u, w_pool, pool_scale, grid_w):
    B, T, _ = u.shape
    uf = u.astype(jnp.float32).reshape(B, T, N_GROUPS_B, GROUP_B)
    outs = []
    for gi, w in enumerate(POOL_WINDOWS):
        ug = uf[:, :, gi]
        if grid_w is None:
            m = _window_mean(ug, w, 1)
        else:
            rows = T // grid_w
            grid = ug.reshape(B, rows, grid_w, GROUP_B)
            m = _window_mean(_window_mean(grid, w, 2), w, 1).reshape(B, T, GROUP_B)
        outs.append(m - ug)
    d = jnp.stack(outs, axis=2)
    y = jnp.einsum('btgc,gcd->btgd', d, w_pool.astype(jnp.float32)).reshape(B, T, D_B)
    return (y * pool_scale.astype(jnp.float32)).astype(u.dtype)


def _layer(x, cvec, s0, grid_w, w_mod, b_mod, g_pre_mix, g_post_mix, g_pre_ffn, g_post_ffn,
           w_in, conv_w, a_log, dt_bias, g_onorm, w_a_proj, w_pool, pool_scale, w_b_proj, w_o,
           w_up, w_down):
    mod = (jax.nn.silu(cvec) @ w_mod + b_mod).reshape(cvec.shape[0], 1, N_MOD, D_MODEL)
    sh1, sc1, gt1, sh2, sc2, gt2 = (mod[:, :, i] for i in range(N_MOD))
    h = _rmsnorm(x, g_pre_mix) * (1.0 + sc1) + sh1
    qkv, z, a, b, u, gate_a, gate_b = _split_cols(h @ w_in)
    qkv = _short_conv(qkv, conv_w)
    y_a, s_fin = _delta_branch(qkv, z, a, b, s0, a_log, dt_bias, g_onorm)
    y_b = _pool_branch(u, w_pool, pool_scale, grid_w)
    merged = jax.nn.sigmoid(gate_a) * (y_a @ w_a_proj) + jax.nn.sigmoid(gate_b) * (y_b @ w_b_proj)
    x = x + gt1 * _rmsnorm(merged @ w_o, g_post_mix)
    h = _rmsnorm(x, g_pre_ffn) * (1.0 + sc2) + sh2
    gt, up = jnp.split(h @ w_up, 2, axis=-1)
    x = x + gt2 * _rmsnorm((jax.nn.silu(gt) * up) @ w_down, g_post_ffn)
    return x, s_fin


def setup_inputs(seed: int = 0) -> dict:
    key = jax.random.key(seed)
    ks = jax.random.split(key, 24)
    f32 = jnp.float32

    def nrm(k, shape, scale):
        return jax.random.normal(k, shape, f32) * scale

    dt = jnp.exp(jax.random.uniform(ks[14], (DEPTH, 2, N_HEADS_A), f32, math.log(1e-3), math.log(1e-1)))
    return {
        'x_prompt': nrm(ks[0], (BATCH, SEQ, D_MODEL), 1.0),
        'x_sample': nrm(ks[1], (DEC_BATCH, DEC_SEQ, D_MODEL), 1.0),
        'state_delta': nrm(ks[2], (DEC_BATCH, DEPTH, 2, N_HEADS_A, HEAD_K, HEAD_V), HEAD_K ** -0.5),
        'c': nrm(ks[3], (DEC_BATCH, D_MODEL), 1.0),
        'c_ctx': nrm(ks[4], (D_MODEL,), 1.0),
        'w_mod': nrm(ks[5], (DEPTH, D_MODEL, N_MOD * D_MODEL), 0.5 * D_MODEL ** -0.5),
        'b_mod': nrm(ks[6], (DEPTH, N_MOD * D_MODEL), 0.01),
        'g_pre_mix': 1.0 + nrm(ks[7], (DEPTH, D_MODEL), 0.02),
        'g_post_mix': 1.0 + nrm(ks[8], (DEPTH, D_MODEL), 0.02),
        'g_pre_ffn': 1.0 + nrm(ks[9], (DEPTH, D_MODEL), 0.02),
        'g_post_ffn': 1.0 + nrm(ks[10], (DEPTH, D_MODEL), 0.02),
        'w_in': nrm(ks[11], (DEPTH, D_MODEL, D_IN), D_MODEL ** -0.5),
        'conv_w': nrm(ks[12], (DEPTH, CONV_K, 3 * D_A), CONV_K ** -0.5),
        'a_log': jnp.log(jax.random.uniform(ks[13], (DEPTH, 2, N_HEADS_A), f32, 1.0, 16.0)),
        'dt_bias': dt + jnp.log(-jnp.expm1(-dt)),
        'g_onorm': 1.0 + nrm(ks[15], (DEPTH, HEAD_V), 0.02),
        'w_a_proj': nrm(ks[16], (DEPTH, D_A, D_MODEL), D_A ** -0.5),
        'w_pool': nrm(ks[17], (DEPTH, N_GROUPS_B, GROUP_B, GROUP_B), GROUP_B ** -0.5),
        'pool_scale': 1.0 + nrm(ks[18], (DEPTH, D_B), 0.02),
        'w_b_proj': nrm(ks[19], (DEPTH, D_B, D_MODEL), D_B ** -0.5),
        'w_o': nrm(ks[20], (DEPTH, D_MODEL, D_MODEL), D_MODEL ** -0.5),
        'w_up': nrm(ks[21], (DEPTH, D_MODEL, 2 * D_FF), D_MODEL ** -0.5),
        'w_down': nrm(ks[22], (DEPTH, D_FF, D_MODEL), D_FF ** -0.5),
    }


def reference(x_prompt, x_sample, state_delta, c, c_ctx, w_mod, b_mod, g_pre_mix, g_post_mix,
              g_pre_ffn, g_post_ffn, w_in, conv_w, a_log, dt_bias, g_onorm, w_a_proj, w_pool,
              pool_scale, w_b_proj, w_o, w_up, w_down):
    s_zero = jnp.zeros((x_prompt.shape[0], 2, N_HEADS_A, HEAD_K, HEAD_V), jnp.float32)
    y_prompt = x_prompt
    y_sample = x_sample
    ctx_states = []
    for l in range(DEPTH):
        params = (w_mod[l], b_mod[l], g_pre_mix[l], g_post_mix[l], g_pre_ffn[l], g_post_ffn[l],
                  w_in[l], conv_w[l], a_log[l], dt_bias[l], g_onorm[l], w_a_proj[l], w_pool[l],
                  pool_scale[l], w_b_proj[l], w_o[l], w_up[l], w_down[l])
        y_prompt, s_ctx = _layer(y_prompt, c_ctx[None, :], s_zero, None, *params)
        ctx_states.append(s_ctx)
        y_sample, _ = _layer(y_sample, c, state_delta[:, l], GRID_W, *params)
    new_state_delta = jnp.stack(ctx_states, axis=1).astype(x_prompt.dtype)
    return (y_prompt, y_sample, new_state_delta)
```

```cpp
#include <hip/hip_runtime.h>
#include <hip/hip_cooperative_groups.h>
#include <stdint.h>
#include <cstdio>
namespace cg = cooperative_groups;

#ifndef MODE_MEGA
#define MODE_MEGA 1
#endif

typedef __attribute__((ext_vector_type(8))) short bf16x8;
typedef __attribute__((ext_vector_type(4))) float f32x4;
typedef unsigned short u16;
typedef __attribute__((ext_vector_type(4))) unsigned int u32x4;
typedef __attribute__((ext_vector_type(2))) unsigned int u32x2;

constexpr int D = 1024;
constexpr int NT = 20480;
constexpr int NCTX = 4096;
constexpr int DFF = 2816;
constexpr float EPS = 1e-6f;
constexpr float QSCALE = 0.08838834764831845f;

constexpr size_t MiB = 1048576;
constexpr size_t OFF_WT_IN = 0;
constexpr size_t OFF_WT_UP = OFF_WT_IN + (size_t)4864 * 1024 * 2;
constexpr size_t OFF_WT_DOWN = OFF_WT_UP + (size_t)5632 * 1024 * 2;
constexpr size_t OFF_WT_O = OFF_WT_DOWN + (size_t)1024 * 2816 * 2;
constexpr size_t OFF_WT_A = OFF_WT_O + (size_t)1024 * 1024 * 2;
constexpr size_t OFF_WT_B = OFF_WT_A + (size_t)1024 * 512 * 2;
constexpr size_t OFF_WT_POOL = OFF_WT_B + (size_t)1024 * 512 * 2;
constexpr size_t OFF_WT_END = OFF_WT_POOL + (size_t)512 * 512 * 2;
static_assert(OFF_WT_END <= 32 * MiB, "weights");
constexpr size_t OFF_MOD = 32 * MiB;
constexpr size_t OFF_AB = 32 * MiB + 262144;
constexpr size_t OFF_EG = 34 * MiB;
constexpr size_t OFF_BETA = OFF_EG + (size_t)2560 * 64 * 4;
constexpr size_t OFF_EKD = OFF_BETA + (size_t)2560 * 64 * 4;
constexpr size_t OFF_BAR = 36 * MiB - 16384;
constexpr size_t OFF_PROG = OFF_BAR + 3456 * 4;
constexpr size_t OFF_H1 = 36 * MiB;
constexpr size_t OFF_DP = 36 * MiB;
constexpr size_t OFF_YB = 56 * MiB;
constexpr size_t OFF_PQKV = 76 * MiB;
constexpr size_t OFF_TINV = 76 * MiB;
constexpr size_t OFF_INTRA = 96 * MiB;
constexpr size_t OFF_KT = 116 * MiB;
constexpr size_t OFF_YA = 76 * MiB;
constexpr size_t OFF_PPOOL = 136 * MiB;
constexpr size_t OFF_OF = 136 * MiB;
constexpr size_t OFF_PZ = 156 * MiB;
constexpr size_t OFF_QKV = 176 * MiB;
constexpr size_t OFF_OB = 236 * MiB;
constexpr size_t OFF_MG = 176 * MiB;
constexpr size_t OFF_T1 = 76 * MiB;
constexpr size_t OFF_H2 = 216 * MiB;
constexpr size_t OFF_ACT = 36 * MiB;
constexpr size_t OFF_T2 = 196 * MiB;
constexpr size_t OFF_X1 = 156 * MiB;

struct Params {
  const float *x_prompt, *x_sample, *state_delta, *c, *c_ctx, *w_mod, *b_mod, *g_pre_mix, *g_post_mix, *g_pre_ffn,
      *g_post_ffn, *w_in, *conv_w, *a_log, *dt_bias, *g_onorm, *w_a_proj, *w_pool, *pool_scale, *w_b_proj, *w_o, *w_up,
      *w_down;
  float* out;
  unsigned char* ws;
};

typedef __bf16 bf16x2_t __attribute__((ext_vector_type(2)));
typedef float f32x2_t __attribute__((ext_vector_type(2)));
__device__ __forceinline__ uint32_t pack2(float a, float b) {
  f32x2_t v = {a, b};
  return __builtin_bit_cast(uint32_t, __builtin_convertvector(v, bf16x2_t));
}
__device__ __forceinline__ u16 f2bf(float f) { return (u16)(pack2(f, f) & 0xffffu); }
__device__ __forceinline__ float bf2f(u16 h) { return __uint_as_float(((uint32_t)h) << 16); }
__device__ __forceinline__ float lo2f(uint32_t u) { return __uint_as_float(u << 16); }
__device__ __forceinline__ float hi2f(uint32_t u) { return __uint_as_float(u & 0xffff0000u); }
__device__ __forceinline__ void unpack8(const uint4& u, float* f) {
  f[0] = lo2f(u.x); f[1] = hi2f(u.x); f[2] = lo2f(u.y); f[3] = hi2f(u.y);
  f[4] = lo2f(u.z); f[5] = hi2f(u.z); f[6] = lo2f(u.w); f[7] = hi2f(u.w);
}
__device__ __forceinline__ float sigmoidf_(float x) { return __builtin_amdgcn_rcpf(1.f + __expf(-x)); }
__device__ __forceinline__ float siluf_(float x) { return x * __builtin_amdgcn_rcpf(1.f + __expf(-x)); }
__device__ __forceinline__ int opaque_tid() {
  int t = threadIdx.x;
  asm volatile("" : "+v"(t));
  return t;
}
__device__ __forceinline__ float wave_sum_dpp(float v) {
  int x = __float_as_int(v);
  v += __int_as_float(__builtin_amdgcn_update_dpp(0, x, 0xB1, 0xF, 0xF, false));
  x = __float_as_int(v);
  v += __int_as_float(__builtin_amdgcn_update_dpp(0, x, 0x4E, 0xF, 0xF, false));
  x = __float_as_int(v);
  v += __int_as_float(__builtin_amdgcn_update_dpp(0, x, 0x124, 0xF, 0xF, false));
  x = __float_as_int(v);
  v += __int_as_float(__builtin_amdgcn_update_dpp(0, x, 0x128, 0xF, 0xF, false));
  x = __float_as_int(v);
  v += __int_as_float(__builtin_amdgcn_update_dpp(0, x, 0x142, 0xA, 0xF, false));
  x = __float_as_int(v);
  v += __int_as_float(__builtin_amdgcn_update_dpp(0, x, 0x143, 0xC, 0xF, false));
  return __int_as_float(__builtin_amdgcn_readlane(__float_as_int(v), 63));
}
__device__ __forceinline__ void store_pair16(u16* rowp, int lane, int i0, uint32_t a0, uint32_t a1, uint32_t b0, uint32_t b1) {
  const uint32_t na0 = (uint32_t)__builtin_amdgcn_update_dpp(0, (int)a0, 0xB1, 0xF, 0xF, false);
  const uint32_t na1 = (uint32_t)__builtin_amdgcn_update_dpp(0, (int)a1, 0xB1, 0xF, 0xF, false);
  const uint32_t nb0 = (uint32_t)__builtin_amdgcn_update_dpp(0, (int)b0, 0xB1, 0xF, 0xF, false);
  const uint32_t nb1 = (uint32_t)__builtin_amdgcn_update_dpp(0, (int)b1, 0xB1, 0xF, 0xF, false);
  const bool odd = lane & 1;
  const uint4 v = odd ? make_uint4(nb0, nb1, b0, b1) : make_uint4(a0, a1, na0, na1);
  const int col = odd ? ((lane - 1) + (i0 + 1) * 64) * 4 : (lane + i0 * 64) * 4;
  *(uint4*)(rowp + col) = v;
}
__device__ __forceinline__ float wave_sum(float v) {
#pragma unroll
  for (int o = 32; o > 0; o >>= 1) v += __shfl_xor(v, o);
  return v;
}

constexpr int SMEM_BYTES = 144 * 1024;
constexpr int TILE_B = 256 * 64 * 2;
constexpr int STAGE_B = 2 * TILE_B;
typedef __attribute__((address_space(3))) unsigned lds_u32;

__device__ __forceinline__ int lds_byte(int r, int c) {
  int st = (r >> 4) * 2 + (c >> 5), ob = (r & 15) * 64 + (c & 31) * 2;
  return st * 1024 + (ob ^ (((ob >> 9) & 1) << 5));
}
__device__ __forceinline__ void stage_rc(int b, int& R, int& C) {
  int st = b >> 10, sb = b & 1023, swz = sb ^ (((sb >> 9) & 1) << 5);
  R = (st >> 1) * 16 + swz / 64;
  C = (st & 1) * 32 + (swz % 64) / 2;
}

template <int MI>
__device__ __forceinline__ void gemm_tile_acc(const u16* __restrict__ A, int lda, const u16* __restrict__ Bt, int ldb,
                                              int K, char* shm, f32x4 (&acc)[MI][4]) {
  constexpr int NCH_A = MI * 4;
  const int tid = opaque_tid(), lane = tid & 63, wid = tid >> 6, wr = wid >> 2, wc = wid & 3, fr = lane & 15, fq = lane >> 4;
  const u16* pa[4];
  const u16* pb[4];
#pragma unroll
  for (int i = 0; i < 4; i++) {
    int R, C;
    stage_rc(wid * 1024 + i * 8192 + lane * 16, R, C);
    pa[i] = A + (size_t)R * lda + C;
    pb[i] = Bt + (size_t)R * ldb + C;
  }
#define GLDS_STAGE(buf, kt)                                                                                          \
  do {                                                                                                               \
    _Pragma("unroll") for (int i = 0; i < 4; i++) {                                                                  \
      if (wid + i * 8 < NCH_A)                                                                                       \
        __builtin_amdgcn_global_load_lds((const unsigned*)(pa[i] + (kt) * 64),                                       \
                                         (lds_u32*)(shm + (buf) * STAGE_B + wid * 1024 + i * 8192), 16, 0, 0);        \
      __builtin_amdgcn_global_load_lds((const unsigned*)(pb[i] + (kt) * 64),                                         \
                                       (lds_u32*)(shm + (buf) * STAGE_B + TILE_B + wid * 1024 + i * 8192), 16, 0, 0); \
    }                                                                                                                \
  } while (0)
  const int nt = K >> 6;
  GLDS_STAGE(0, 0);
  asm volatile("s_waitcnt vmcnt(0)" ::: "memory");
  __syncthreads();
  for (int t = 0; t < nt; t++) {
    const int cur = t & 1;
    if (t + 1 < nt) GLDS_STAGE(cur ^ 1, t + 1);
    const char* sa = shm + cur * STAGE_B;
    const char* sb = sa + TILE_B;
#pragma unroll
    for (int ks = 0; ks < 2; ks++) {
      bf16x8 At[MI], Bf[4];
#pragma unroll
      for (int m = 0; m < MI; m++) At[m] = *(const bf16x8*)(sa + lds_byte(wr * (MI * 16) + m * 16 + fr, ks * 32 + fq * 8));
#pragma unroll
      for (int n = 0; n < 4; n++) Bf[n] = *(const bf16x8*)(sb + lds_byte(wc * 64 + n * 16 + fr, ks * 32 + fq * 8));
      __builtin_amdgcn_iglp_opt(0);
      __builtin_amdgcn_s_setprio(1);
#pragma unroll
      for (int m = 0; m < MI; m++)
#pragma unroll
        for (int n = 0; n < 4; n++)
          acc[m][n] = __builtin_amdgcn_mfma_f32_16x16x32_bf16(Bf[n], At[m], acc[m][n], 0, 0, 0);
      __builtin_amdgcn_s_setprio(0);
    }
    asm volatile("s_waitcnt vmcnt(0)" ::: "memory");
    __syncthreads();
  }
#undef GLDS_STAGE
}

template <int MI>
__device__ __forceinline__ void zero_acc(f32x4 (&acc)[MI][4]) {
#pragma unroll
  for (int i = 0; i < MI; i++)
#pragma unroll
    for (int j = 0; j < 4; j++) acc[i][j] = f32x4{0.f, 0.f, 0.f, 0.f};
}

__device__ __forceinline__ void store16_bf16(u16* dst, const f32x4 (&a)[4]) {
  *(uint4*)dst = make_uint4(pack2(a[0][0], a[0][1]), pack2(a[0][2], a[0][3]), pack2(a[1][0], a[1][1]), pack2(a[1][2], a[1][3]));
  *(uint4*)(dst + 8) = make_uint4(pack2(a[2][0], a[2][1]), pack2(a[2][2], a[2][3]), pack2(a[3][0], a[3][1]), pack2(a[3][2], a[3][3]));
}
__device__ __forceinline__ void load16_bf16(const u16* src, float (&g)[16]) {
  float lo[8], hi[8];
  unpack8(*(const uint4*)src, lo);
  unpack8(*(const uint4*)(src + 8), hi);
#pragma unroll
  for (int i = 0; i < 8; i++) { g[i] = lo[i]; g[8 + i] = hi[i]; }
}

template <class F>
__device__ __forceinline__ void for_tiles(int nM, int nN, F f, int bid = blockIdx.x, int G = gridDim.x) {
  const int nT = nM * nN;
  const int GM = 8;
  const int gfull = GM * nN;
  const bool sw = (G & 7) == 0;
  const int per = sw ? ((nT + 7) >> 3) : nT;
  const int start = sw ? (bid >> 3) : bid;
  const int stride = sw ? (G >> 3) : G;
  const int base = sw ? (bid & 7) * per : 0;
  for (int q = start; q < per; q += stride) {
    const int id = base + q;
    if (id >= nT) break;
    const int g = id / gfull, r = id - g * gfull;
    const int gsz = min(GM, nM - g * GM);
    f(g * GM + r % gsz, r / gsz);
  }
}

#define TILE_COORDS                                                                                         \
  const int tid = opaque_tid(), lane = tid & 63, w = tid >> 6, wr = w >> 2, wc = w & 3, fr = lane & 15, \
            fq = lane >> 4;                                                                                 \
  (void)tid; (void)lane; (void)w; (void)wr; (void)wc; (void)fr; (void)fq;

__device__ __forceinline__ int perm64(int c) { return (c & ~63) | (((c >> 2) & 3) << 4) | (((c >> 4) & 3) << 2) | (c & 3); }
__device__ __forceinline__ int maprow(int mode, int n) {
  if (mode == 1) {
    int r;
    if (n < 2048) r = n;
    else if (n < 2064) r = 4608 + (n - 2048);
    else if (n < 2576) r = 2048 + (n - 2064);
    else if (n < 4624) r = 2560 + (n - 2576);
    else r = n;
    return perm64(r);
  } else if (mode == 2) {
    const int up = n >= DFF;
    const int j = up ? n - DFF : n;
    const int jo = j & 31;
    return (j >> 5) * 64 + up * 32 + ((jo >> 2) & 1) * 16 + (jo >> 3) * 4 + (jo & 3);
  }
  return perm64(n);
}

struct TrDesc {
  const float* src;
  u16* dst;
  int srcN, nvalid, k0, n0, dst_ld, mode;
};

__device__ __forceinline__ TrDesc tr_decode(const Params& p, int id) {
  TrDesc d;
  d.mode = 0;
  if (id < 1216) {
    d.src = p.w_in; d.srcN = 4624; d.nvalid = 4624; d.k0 = (id & 15) * 64; d.n0 = (id >> 4) * 64;
    d.dst = (u16*)(p.ws + OFF_WT_IN); d.dst_ld = 1024; d.mode = 1;
    return d;
  }
  id -= 1216;
  if (id < 1408) {
    d.src = p.w_up; d.srcN = 5632; d.nvalid = 5632; d.k0 = (id & 15) * 64; d.n0 = (id >> 4) * 64;
    d.dst = (u16*)(p.ws + OFF_WT_UP); d.dst_ld = 1024; d.mode = 2;
    return d;
  }
  id -= 1408;
  if (id < 704) {
    d.src = p.w_down; d.srcN = 1024; d.nvalid = 1024; d.k0 = (id % 44) * 64; d.n0 = (id / 44) * 64;
    d.dst = (u16*)(p.ws + OFF_WT_DOWN); d.dst_ld = 2816;
    return d;
  }
  id -= 704;
  if (id < 256) {
    d.src = p.w_o; d.srcN = 1024; d.nvalid = 1024; d.k0 = (id & 15) * 64; d.n0 = (id >> 4) * 64;
    d.dst = (u16*)(p.ws + OFF_WT_O); d.dst_ld = 1024;
    return d;
  }
  id -= 256;
  if (id < 128) {
    d.src = p.w_a_proj; d.srcN = 1024; d.nvalid = 1024; d.k0 = (id & 7) * 64; d.n0 = (id >> 3) * 64;
    d.dst = (u16*)(p.ws + OFF_WT_A); d.dst_ld = 512;
    return d;
  }
  id -= 128;
  if (id < 128) {
    d.src = p.w_b_proj; d.srcN = 1024; d.nvalid = 1024; d.k0 = (id & 7) * 64; d.n0 = (id >> 3) * 64;
    d.dst = (u16*)(p.ws + OFF_WT_B); d.dst_ld = 512;
    return d;
  }
  id -= 128;
  {
    const int kt = id & 7, ntile = id >> 3;
    const int g = kt >> 1;
    u16* base = (u16*)(p.ws + OFF_WT_POOL);
    d.dst_ld = 512;
    if ((ntile >> 1) == g) {
      d.src = p.w_pool + g * 16384; d.srcN = 128; d.nvalid = 128; d.k0 = (kt & 1) * 64; d.n0 = (ntile & 1) * 64;
      d.dst = base + (size_t)(g * 128) * 512 + g * 128;
    } else {
      d.src = p.w_pool; d.srcN = 128; d.nvalid = 0; d.k0 = kt * 64; d.n0 = ntile * 64;
      d.dst = base;
    }
    return d;
  }
}
constexpr int N_TR_TILES = 1216 + 1408 + 704 + 256 + 128 + 128 + 64;

__device__ void tr_tile(const TrDesc& d, float* sm, int ltid) {
  const int c = ltid & 63, r4 = ltid >> 6;
  const int n = d.n0 + c;
  const bool nv = n < d.nvalid;
  float tv[16];
#pragma unroll
  for (int i = 0; i < 16; i++) tv[i] = nv ? d.src[(size_t)(d.k0 + r4 + i * 4) * d.srcN + n] : 0.f;
#pragma unroll
  for (int i = 0; i < 16; i++) sm[(r4 + i * 4) * 65 + c] = tv[i];
  __syncthreads();
  const int nr = ltid >> 2, kq = (ltid & 3) * 16;
  const int nd = maprow(d.mode, d.n0 + nr);
  uint32_t pk[8];
#pragma unroll
  for (int j = 0; j < 8; j++) pk[j] = pack2(sm[(kq + 2 * j) * 65 + nr], sm[(kq + 2 * j + 1) * 65 + nr]);
  uint4* o = (uint4*)(d.dst + (size_t)nd * d.dst_ld + d.k0 + kq);
  o[0] = make_uint4(pk[0], pk[1], pk[2], pk[3]);
  o[1] = make_uint4(pk[4], pk[5], pk[6], pk[7]);
  __syncthreads();
}

__device__ void mod_item(const Params& p, int item, float* sm) {
  const int tid = opaque_tid();
  for (int i = tid; i < 9 * 1024; i += 512) {
    int cv = i >> 10, k = i & 1023;
    float cval = (cv < 8) ? p.c[cv * 1024 + k] : p.c_ctx[k];
    sm[i] = siluf_(cval);
  }
  __syncthreads();
  const int cl = tid & 63, kg = tid >> 6;
  const int n = item * 64 + cl;
  float acc[9];
#pragma unroll
  for (int cv = 0; cv < 9; cv++) acc[cv] = 0.f;
  const float* wp = p.w_mod + (size_t)(kg * 128) * 6144 + n;
#pragma unroll 16
  for (int k = 0; k < 128; k++) {
    float wv = wp[(size_t)k * 6144];
#pragma unroll
    for (int cv = 0; cv < 9; cv++) acc[cv] += sm[cv * 1024 + kg * 128 + k] * wv;
  }
  __syncthreads();
  float* red = sm + 9 * 1024;
#pragma unroll
  for (int cv = 0; cv < 9; cv++) red[(kg * 9 + cv) * 64 + cl] = acc[cv];
  __syncthreads();
  float* MOD = (float*)(p.ws + OFF_MOD);
  for (int i = tid; i < 9 * 64; i += 512) {
    int cv = i >> 6, c2 = i & 63;
    float s = 0.f;
#pragma unroll
    for (int g = 0; g < 8; g++) s += red[(g * 9 + cv) * 64 + c2];
    MOD[cv * 6144 + item * 64 + c2] = s + p.b_mod[item * 64 + c2];
  }
  __syncthreads();
}

__device__ void phase_prep(const Params& p, char* smem) {
  float* sm = (float*)smem;
  const int tidx = opaque_tid();
  const int half = tidx >> 8, ltid = tidx & 255;
  constexpr int N_MOD_IT = 96;
  constexpr int N_EARLY = 1216 + 64;
  for (int it = blockIdx.x; it < N_MOD_IT + N_EARLY / 2; it += gridDim.x) {
    if (it < N_MOD_IT) {
      mod_item(p, it, sm);
    } else {
      int id = (it - N_MOD_IT) * 2 + half;
      if (id >= 1216) id += N_TR_TILES - 64 - 1216;
      TrDesc d = tr_decode(p, id);
      tr_tile(d, sm + half * (64 * 65), ltid);
    }
  }
}

__device__ void deferred_weight_prep(const Params& p, char* smem, int worker, int nworkers) {
  float* sm = (float*)smem;
  const int tidx = opaque_tid();
  const int half = tidx >> 8, ltid = tidx & 255;
  constexpr int N_DEF = N_TR_TILES - 64 - 1216;
  for (int it = worker; it < N_DEF / 2; it += nworkers) {
    TrDesc d = tr_decode(p, 1216 + it * 2 + half);
    tr_tile(d, sm + half * (64 * 65), ltid);
  }
}

__device__ __forceinline__ const float* xrow(const Params& p, int t) {
  return t < NCTX ? p.x_prompt + (size_t)t * D : p.x_sample + (size_t)(t - NCTX) * D;
}
__device__ __forceinline__ int cvof(int t) { return t < NCTX ? 8 : ((t - NCTX) >> 11); }
__device__ __forceinline__ float sq4(const float4& v) { return v.x * v.x + v.y * v.y + v.z * v.z + v.w * v.w; }

__device__ void phase_h1(const Params& p) {
  const int tidx = opaque_tid();
  const int lane = tidx & 63;
  const int nwb = blockDim.x >> 6;
  const int gw = blockIdx.x * nwb + (tidx >> 6), nw = gridDim.x * nwb;
  const float* MOD = (const float*)(p.ws + OFF_MOD);
  u16* H1 = (u16*)(p.ws + OFF_H1);
  for (int tb = gw; tb < NT; tb += 2 * nw) {
    float4 v[2][4];
    float ss[2];
#pragma unroll
    for (int u = 0; u < 2; u++) {
      const int t = min(tb + u * nw, NT - 1);
      const float4* x = (const float4*)xrow(p, t);
#pragma unroll
      for (int i = 0; i < 4; i++) v[u][i] = x[lane + i * 64];
    }
#pragma unroll
    for (int u = 0; u < 2; u++) {
      ss[u] = 0.f;
#pragma unroll
      for (int i = 0; i < 4; i++) ss[u] += sq4(v[u][i]);
      ss[u] = wave_sum(ss[u]);
    }
#pragma unroll
    for (int u = 0; u < 2; u++) {
      const int t = tb + u * nw;
      if (t < NT) {
        const float* mod = MOD + cvof(t) * 6144;
        const float rstd = rsqrtf(ss[u] * (1.f / 1024.f) + EPS);
        uint32_t hp[4][2];
#pragma unroll
        for (int i = 0; i < 4; i++) {
          const int col = (lane + i * 64) * 4;
          const float4 g = *(const float4*)(p.g_pre_mix + col);
          const float4 sh = *(const float4*)(mod + col);
          const float4 sc = *(const float4*)(mod + 1024 + col);
          float h0 = v[u][i].x * rstd * g.x * (1.f + sc.x) + sh.x;
          float h1 = v[u][i].y * rstd * g.y * (1.f + sc.y) + sh.y;
          float h2 = v[u][i].z * rstd * g.z * (1.f + sc.z) + sh.z;
          float h3 = v[u][i].w * rstd * g.w * (1.f + sc.w) + sh.w;
          hp[i][0] = pack2(h0, h1);
          hp[i][1] = pack2(h2, h3);
        }
        store_pair16(H1 + (size_t)t * D, lane, 0, hp[0][0], hp[0][1], hp[1][0], hp[1][1]);
        store_pair16(H1 + (size_t)t * D, lane, 2, hp[2][0], hp[2][1], hp[3][0], hp[3][1]);
      }
    }
  }
}

__device__ void phase_gemm_in(const Params& p, char* smem) {
  const u16* H1 = (const u16*)(p.ws + OFF_H1);
  const u16* WT = (const u16*)(p.ws + OFF_WT_IN);
  u16* Pqkv = (u16*)(p.ws + OFF_PQKV);
  u16* Pz = (u16*)(p.ws + OFF_PZ);
  u16* Ppool = (u16*)(p.ws + OFF_PPOOL);
  u16* Pgate = (u16*)p.out;
  float* AB = (float*)(p.ws + OFF_AB);
  TILE_COORDS
  for_tiles(80, 19, [&](int m, int n) {
    f32x4 acc[8][4];
    zero_acc(acc);
    gemm_tile_acc(H1 + (size_t)m * 256 * 1024, 1024, WT + (size_t)n * 256 * 1024, 1024, 1024, smem, acc);
    const int n0 = n * 256;
    u16* dst;
    int ld, cb;
    bool sig = false;
    if (n0 < 1536) { dst = Pqkv; ld = 1536; cb = n0; }
    else if (n0 < 2048) { dst = Pz; ld = 512; cb = n0 - 1536; }
    else if (n0 < 2560) { dst = Ppool; ld = 512; cb = n0 - 2048; }
    else if (n0 < 4608) { dst = Pgate; ld = 2048; cb = n0 - 2560; sig = true; }
    else { dst = nullptr; ld = 0; cb = 0; }
#pragma unroll
    for (int mi = 0; mi < 8; mi++) {
      const int row = m * 256 + wr * 128 + mi * 16 + fr;
      if (dst) {
        f32x4 a[4];
#pragma unroll
        for (int ni = 0; ni < 4; ni++) {
          a[ni] = acc[mi][ni];
          if (sig) { a[ni][0] = sigmoidf_(a[ni][0]); a[ni][1] = sigmoidf_(a[ni][1]); a[ni][2] = sigmoidf_(a[ni][2]); a[ni][3] = sigmoidf_(a[ni][3]); }
        }
        store16_bf16(dst + (size_t)row * ld + cb + wc * 64 + fq * 16, a);
      } else if (wc == 0 && fq == 0) {
#pragma unroll
        for (int ni = 0; ni < 4; ni++) {
          f32x4 v = acc[mi][ni];
          *(float4*)(AB + (size_t)row * 16 + ni * 4) = make_float4(v[0], v[1], v[2], v[3]);
        }
      }
    }
  });
}

__device__ __forceinline__ void add8(float* s, const uint4& u) {
  s[0] += lo2f(u.x); s[1] += hi2f(u.x); s[2] += lo2f(u.y); s[3] += hi2f(u.y);
  s[4] += lo2f(u.z); s[5] += hi2f(u.z); s[6] += lo2f(u.w); s[7] += hi2f(u.w);
}

template <int HW>
__device__ __forceinline__ void pool_lat_item(const u16* __restrict__ Ppool, u16* __restrict__ Dp, int b, int rb, int cv,
                                              int lane) {
  constexpr int NR = 8 + 2 * HW;
  const int base = NCTX + b * 2048;
  const int r0 = rb * 8;
  const int col = cv * 8;
  uint4 U[NR];
#pragma unroll
  for (int k = 0; k < NR; k++) {
    const int r = r0 - HW + k;
    const int rc = min(max(r, 0), 31);
    const uint4 v = *(const uint4*)(Ppool + (size_t)(base + rc * 64 + lane) * 512 + col);
    U[k] = (r == rc) ? v : make_uint4(0, 0, 0, 0);
  }
  const int clo = max(lane - HW, 0), chi = min(lane + HW, 64);
  const float cntc = (float)(chi - clo);
#pragma unroll
  for (int i = 0; i < 8; i++) {
    const int r = r0 + i;
    float V[8];
#pragma unroll
    for (int j = 0; j < 8; j++) V[j] = 0.f;
#pragma unroll
    for (int k = 0; k < 2 * HW; k++) add8(V, U[i + k]);
    float H[8];
#pragma unroll
    for (int j = 0; j < 8; j++) {
      float a = V[j];
      float b = __int_as_float(__builtin_amdgcn_update_dpp(0, __float_as_int(V[j]), 0x138, 0xF, 0xF, false));
      if (HW > 1) {
        a += __int_as_float(__builtin_amdgcn_update_dpp(0, __float_as_int(a), 0x130, 0xF, 0xF, false));
        b += __int_as_float(__builtin_amdgcn_update_dpp(0, __float_as_int(b), 0x138, 0xF, 0xF, false));
      }
#pragma unroll
      for (int k = 2; k < HW; k <<= 1) {
        float t = __shfl(a, (lane + k) & 63);
        a += (lane + k < 64) ? t : 0.f;
        t = __shfl(b, (lane - k) & 63);
        b += (lane - k >= 0) ? t : 0.f;
      }
      H[j] = a + b;
    }
    const float cntr = (float)(min(r + HW, 32) - max(r - HW, 0));
    const float inv = 1.f / (cntr * cntc);
    float fs[8];
    unpack8(U[i + HW], fs);
    uint4 o;
    o.x = pack2(H[0] * inv - fs[0], H[1] * inv - fs[1]);
    o.y = pack2(H[2] * inv - fs[2], H[3] * inv - fs[3]);
    o.z = pack2(H[4] * inv - fs[4], H[5] * inv - fs[5]);
    o.w = pack2(H[6] * inv - fs[6], H[7] * inv - fs[7]);
    *(uint4*)(Dp + (size_t)(base + r * 64 + lane) * 512 + col) = o;
  }
}

template <int HW>
__device__ __forceinline__ void pool_ctx_item(const u16* __restrict__ Ppool, u16* __restrict__ Dp, int sg, int cv, int lane) {
  const int t = sg * 64 + lane;
  const int s_lo = t & ~255, pos = t - s_lo;
  const int col = cv * 8;
  uint4 U[2 * HW];
#pragma unroll
  for (int k = 0; k < 2 * HW; k++) {
    const int tt = pos - HW + k;
    const int tcl = min(max(tt, 0), 255);
    const uint4 v = *(const uint4*)(Ppool + (size_t)(s_lo + tcl) * 512 + col);
    U[k] = (tt == tcl) ? v : make_uint4(0, 0, 0, 0);
  }
  float S[8];
#pragma unroll
  for (int j = 0; j < 8; j++) S[j] = 0.f;
#pragma unroll
  for (int k = 0; k < 2 * HW; k++) add8(S, U[k]);
  const float inv = 1.f / (float)(min(pos + HW, 256) - max(pos - HW, 0));
  float fs[8];
  unpack8(U[HW], fs);
  uint4 o;
  o.x = pack2(S[0] * inv - fs[0], S[1] * inv - fs[1]);
  o.y = pack2(S[2] * inv - fs[2], S[3] * inv - fs[3]);
  o.z = pack2(S[4] * inv - fs[4], S[5] * inv - fs[5]);
  o.w = pack2(S[6] * inv - fs[6], S[7] * inv - fs[7]);
  *(uint4*)(Dp + (size_t)t * 512 + col) = o;
}

__device__ void phase_conv_pool(const Params& p) {
  const int tidx = opaque_tid();
  const int lane0 = tidx & 63;
  const int nwb = blockDim.x >> 6;
  const int gw = blockIdx.x * nwb + (tidx >> 6), nw = gridDim.x * nwb;
  const u16* Pqkv = (const u16*)(p.ws + OFF_PQKV);
  const u16* Ppool = (const u16*)(p.ws + OFF_PPOOL);
  u16* QKV = (u16*)(p.ws + OFF_QKV);
  u16* Dp = (u16*)(p.ws + OFF_DP);
  for (int id = gw; id < 320 * 12; id += nw) {
    int lane = lane0;
    asm volatile("" : "+v"(lane));
    const int cg_ = id / 12, gq = id - cg_ * 12;
    int s_lo, s_hi;
    if (cg_ < 64) { s_lo = (cg_ >> 2) << 8; s_hi = s_lo + 256; }
    else { s_lo = NCTX + (((cg_ - 64) >> 5) << 11); s_hi = s_lo + 2048; }
    const int col = gq * 128 + lane * 2;
    float w0[5], w1[5];
#pragma unroll
    for (int j = 0; j < 5; j++) {
      float2 wv = *(const float2*)(p.conv_w + j * 1536 + col);
      w0[j] = wv.x; w1[j] = wv.y;
    }
    const int t0 = cg_ * 64;
    for (int sb = 0; sb < 4; sb++) {
      const int tb = t0 + sb * 16;
      uint32_t raw[20];
#pragma unroll
      for (int i = 0; i < 20; i++) {
        const int t = tb - 2 + i;
        const int tc = min(max(t, s_lo), s_hi - 1);
        const uint32_t v = *(const uint32_t*)(Pqkv + (size_t)tc * 1536 + col);
        raw[i] = (t == tc) ? v : 0u;
      }
#pragma unroll
      for (int i = 0; i < 16; i++) {
        float y0 = 0.f, y1 = 0.f;
#pragma unroll
        for (int j = 0; j < 5; j++) {
          y0 += w0[j] * lo2f(raw[i + j]);
          y1 += w1[j] * hi2f(raw[i + j]);
        }
        y0 = siluf_(y0); y1 = siluf_(y1);
        if (gq < 8) {
          float ss = wave_sum_dpp(y0 * y0 + y1 * y1);
          float sc = rsqrtf(ss + EPS);
          y0 *= sc; y1 *= sc;
        }
        *(uint32_t*)(QKV + (size_t)(tb + i) * 1536 + col) = pack2(y0, y1);
      }
    }
  }
  for (int id = gw; id < 2048; id += nw) {
    const int cv = id & 63, rb = (id >> 6) & 3, b = id >> 8;
    const int gi = cv >> 4;
    int lane = lane0;
    asm volatile("" : "+v"(lane));
    if (gi == 0) pool_lat_item<1>(Ppool, Dp, b, rb, cv, lane);
    else if (gi == 1) pool_lat_item<2>(Ppool, Dp, b, rb, cv, lane);
    else if (gi == 2) pool_lat_item<4>(Ppool, Dp, b, rb, cv, lane);
    else pool_lat_item<8>(Ppool, Dp, b, rb, cv, lane);
  }
  for (int id = gw; id < 4096; id += nw) {
    const int cv = id & 63, sg = id >> 6;
    const int gi = cv >> 4;
    int lane = lane0;
    asm volatile("" : "+v"(lane));
    if (gi == 0) pool_ctx_item<1>(Ppool, Dp, sg, cv, lane);
    else if (gi == 1) pool_ctx_item<2>(Ppool, Dp, sg, cv, lane);
    else if (gi == 2) pool_ctx_item<4>(Ppool, Dp, sg, cv, lane);
    else pool_ctx_item<8>(Ppool, Dp, sg, cv, lane);
  }
}

constexpr int PRE_LDS_BYTES = 70656;
__device__ void pre_item(const Params& p, int cg_, int h, char* smem_half) {
  u16* sq = (u16*)smem_half;
  u16* sk = sq + 64 * 136;
  float* sL = (float*)(sk + 64 * 136);
  float* ssc = sL + 2 * 64 * 68;
  const u16* QKV = (const u16*)(p.ws + OFF_QKV);
  const float* AB = (const float*)(p.ws + OFF_AB);
  u16* TINV = (u16*)(p.ws + OFF_TINV);
  u16* INTRA = (u16*)(p.ws + OFF_INTRA);
  float* EG = (float*)(p.ws + OFF_EG);
  float* BETA = (float*)(p.ws + OFF_BETA);
  float* EKD = (float*)(p.ws + OFF_EKD);
  int tid = threadIdx.x & 255;
  asm volatile("" : "+v"(tid));
  const int lane = tid & 63, w = tid >> 6, fr = lane & 15, fq = lane >> 4;
  const int t0 = cg_ * 64;
  const int item = cg_ * 4 + h;
  {
    uint4 lq[4], lk[4];
#pragma unroll
    for (int i = 0; i < 4; i++) {
      int c = tid + i * 256;
      int row = c >> 4, kc = (c & 15) * 8;
      const u16* src = QKV + (size_t)(t0 + row) * 1536 + h * 128 + kc;
      lq[i] = *(const uint4*)src;
      lk[i] = *(const uint4*)(src + 512);
    }
#pragma unroll
    for (int i = 0; i < 4; i++) {
      int c = tid + i * 256;
      int row = c >> 4, kc = (c & 15) * 8;
      *(uint4*)(sq + row * 136 + kc) = lq[i];
      *(uint4*)(sk + row * 136 + kc) = lk[i];
    }
  }
  if (tid < 128) {
    const int d = tid >> 6, i = tid & 63;
    const float a = AB[(size_t)(t0 + i) * 16 + d * 4 + h];
    const float b = AB[(size_t)(t0 + i) * 16 + 8 + d * 4 + h];
    const float xs = a + p.dt_bias[d * 4 + h];
    const float sp = xs > 20.f ? xs : log1pf(__expf(xs));
    const float g = -__expf(p.a_log[d * 4 + h]) * sp;
    const float beta = sigmoidf_(b);
    float v = g;
    if (d == 0) {
#pragma unroll
      for (int o = 1; o < 64; o <<= 1) { float u = __shfl_up(v, o); if (lane >= o) v += u; }
    } else {
#pragma unroll
      for (int o = 1; o < 64; o <<= 1) { float u = __shfl_down(v, o); if (lane + o < 64) v += u; }
    }
    const float gl = __shfl(v, d == 0 ? 63 : 0);
    ssc[d * 64 + i] = v;
    ssc[128 + d * 64 + i] = beta;
    const size_t so = (size_t)(item * 2 + d) * 64 + i;
    EG[so] = __expf(v);
    BETA[so] = __expf(gl);
    EKD[so] = __expf(gl - v);
  }
  __syncthreads();
  {
    bf16x8 ak[4], aq[4];
#pragma unroll
    for (int ks = 0; ks < 4; ks++) {
      ak[ks] = *(const bf16x8*)(sk + (16 * w + fr) * 136 + ks * 32 + fq * 8);
      aq[ks] = *(const bf16x8*)(sq + (16 * w + fr) * 136 + ks * 32 + fq * 8);
    }
    float* L0 = sL;
    float* L1 = sL + 64 * 68;
    u16* I0 = INTRA + (size_t)(item * 2 + 0) * 4096;
    u16* I1 = INTRA + (size_t)(item * 2 + 1) * 4096;
#pragma unroll
    for (int jt = 0; jt < 4; jt++) {
      f32x4 aK = {0.f, 0.f, 0.f, 0.f}, aQ = {0.f, 0.f, 0.f, 0.f};
#pragma unroll
      for (int ks = 0; ks < 4; ks++) {
        bf16x8 b = *(const bf16x8*)(sk + (16 * jt + fr) * 136 + ks * 32 + fq * 8);
        aK = __builtin_amdgcn_mfma_f32_16x16x32_bf16(ak[ks], b, aK, 0, 0, 0);
        aQ = __builtin_amdgcn_mfma_f32_16x16x32_bf16(aq[ks], b, aQ, 0, 0, 0);
      }
      const int j = 16 * jt + fr;
      const float gc0j = ssc[j], g1j = ssc[64 + j];
#pragma unroll
      for (int jj = 0; jj < 4; jj++) {
        const int i = 16 * w + fq * 4 + jj;
        const float kkv = aK[jj], qkv = aQ[jj] * QSCALE;
        const float e0 = __expf(fminf(ssc[i] - gc0j, 0.f));
        const float e1 = __expf(fminf(ssc[64 + i] - g1j, 0.f));
        const float l0v = ssc[128 + i] * kkv * e0, l1v = ssc[192 + i] * kkv * e1;
        L0[j * 68 + i] = (i > j) ? l0v : 0.f;
        L1[(63 - j) * 68 + (63 - i)] = (i < j) ? l1v : 0.f;
        I0[i * 64 + j] = f2bf((i >= j) ? qkv * e0 : 0.f);
        I1[i * 64 + j] = f2bf((i <= j) ? qkv * e1 : 0.f);
      }
    }
  }
  __syncthreads();
  if (w < 2) {
    float* Lp = sL + w * 64 * 68;
    const int c = lane;
    float x[64];
#pragma unroll
    for (int i = 0; i < 64; i++) x[i] = (i == c) ? 1.f : 0.f;
#pragma unroll
    for (int j = 0; j < 63; j++) {
      const float xj = x[j];
#pragma unroll
      for (int i4 = (j + 1) / 4; i4 < 16; i4++) {
        const float4 l = *(const float4*)(Lp + j * 68 + i4 * 4);
        if (i4 * 4 + 0 > j) x[i4 * 4 + 0] -= l.x * xj;
        if (i4 * 4 + 1 > j) x[i4 * 4 + 1] -= l.y * xj;
        if (i4 * 4 + 2 > j) x[i4 * 4 + 2] -= l.z * xj;
        if (i4 * 4 + 3 > j) x[i4 * 4 + 3] -= l.w * xj;
      }
      if (j & 1) asm volatile("" ::: "memory");
    }
    u16* sX = (u16*)Lp;
    const float bcol = (w == 0) ? ssc[128 + c] : ssc[192 + 63 - c];
    if (w == 0) {
#pragma unroll
      for (int r = 0; r < 64; r++) sX[r * 64 + c] = f2bf(x[r] * bcol);
    } else {
#pragma unroll
      for (int r = 0; r < 64; r++) sX[(63 - r) * 64 + (63 - c)] = f2bf(x[r] * bcol);
    }
  }
  __syncthreads();
  if (w < 2) {
    const u16* sX = (const u16*)(sL + w * 64 * 68);
    u16* T = TINV + (size_t)(item * 2 + w) * 4096;
#pragma unroll
    for (int i = 0; i < 8; i++) *(uint4*)(T + (i * 64 + lane) * 8) = *(const uint4*)(sX + (i * 64 + lane) * 8);
  }
  __syncthreads();
}

__device__ void phase_pre(const Params& p, char* smem) {
  const int half = opaque_tid() >> 8;
  for (int pr = blockIdx.x; pr < 640; pr += gridDim.x) {
    const int it = pr * 2 + half;
    pre_item(p, it >> 2, it & 3, smem + half * PRE_LDS_BYTES);
  }
}

__device__ __forceinline__ void pool_linear(const Params& p, char* smem, int bid, int G) {
  const u16* Dp = (const u16*)(p.ws + OFF_DP);
  const u16* WTP = (const u16*)(p.ws + OFF_WT_POOL);
  u16* YB = (u16*)(p.ws + OFF_YB);
  TILE_COORDS
  for_tiles(128, 2, [&](int m, int n) {
    f32x4 acc[5][4];
    zero_acc(acc);
    gemm_tile_acc(Dp + (size_t)m * 160 * 512, 512, WTP + (size_t)n * 256 * 512, 512, 512, smem, acc);
#pragma unroll
    for (int mi = 0; mi < 5; mi++) {
      const int row = m * 160 + wr * 80 + mi * 16 + fr;
      const int colb = n * 256 + wc * 64 + fq * 16;
      f32x4 a[4];
#pragma unroll
      for (int ni = 0; ni < 4; ni++) {
        const float4 sc = *(const float4*)(p.pool_scale + colb + ni * 4);
        a[ni] = acc[mi][ni];
        a[ni][0] *= sc.x; a[ni][1] *= sc.y; a[ni][2] *= sc.z; a[ni][3] *= sc.w;
      }
      store16_bf16(YB + (size_t)row * 512 + colb, a);
    }
  }, bid, G);
}

constexpr int SCAN_LDS_U16 = 32 * 136 + 3 * 64 * 72;
constexpr int SCAN_SHARED_U16 = 2 * 64 * 136 + 2 * 64 * 72;
__device__ void scan_chain(const Params& p, int chain, int vq, char* smem_c) {
  const int tidx = opaque_tid();
  const int vh = tidx >> 8;
  const int tid = tidx & 255, lane = tid & 63, w = tid >> 6, fr = lane & 15, fq = lane >> 4;
  const bool lat = chain < 64;
  const int cc = lat ? chain : chain - 64;
  const int sb = cc >> 3, h = (cc >> 1) & 3, d = cc & 1;
  const int cg0 = lat ? 64 + sb * 32 : sb * 4;
  const int nch = lat ? 32 : 4;
  u16* sk = (u16*)smem_c;
  u16* sq = sk + 64 * 136;
  u16* sT = sq + 64 * 136;
  u16* sI = sT + 64 * 72;
  u16* ST = sI + 64 * 72 + vh * SCAN_LDS_U16;
  u16* RT = ST + 32 * 136;
  u16* VNT = RT + 64 * 72;
  u16* VNST = VNT + 64 * 72;
  const u16* QKV = (const u16*)(p.ws + OFF_QKV);
  const u16* TINV = (const u16*)(p.ws + OFF_TINV);
  const u16* INTRA = (const u16*)(p.ws + OFF_INTRA);
  const float* EG = (const float*)(p.ws + OFF_EG);
  const float* EKD = (const float*)(p.ws + OFF_EKD);
  const float* EGLB = (const float*)(p.ws + OFF_BETA);
  u16* OD = (u16*)(p.ws + (d ? OFF_OB : OFF_OF));
  const int voff = vq * 64 + vh * 32;
  const int vbase = h * 128 + voff;

  f32x4 S[2][2];
  if (lat) {
    const float* s0 = p.state_delta + (size_t)((sb * 2 + d) * 4 + h) * 16384;
#pragma unroll
    for (int kt = 0; kt < 2; kt++)
#pragma unroll
      for (int vt = 0; vt < 2; vt++)
#pragma unroll
        for (int jj = 0; jj < 4; jj++)
          S[kt][vt][jj] = s0[(32 * w + kt * 16 + fq * 4 + jj) * 128 + voff + vt * 16 + fr];
  } else {
#pragma unroll
    for (int kt = 0; kt < 2; kt++)
#pragma unroll
      for (int vt = 0; vt < 2; vt++) S[kt][vt] = f32x4{0.f, 0.f, 0.f, 0.f};
  }

  auto chunk_of = [&](int step) { const int st = min(step, nch - 1); return cg0 + (d ? nch - 1 - st : st); };
  u32x4 stg[6];
  auto load_stage = [&](int step) {
    const int cg_ = chunk_of(step);
    const int itd = (cg_ * 4 + h) * 2 + d;
#pragma unroll
    for (int i = 0; i < 2; i++) {
      const int c = tidx + i * 512, row = c >> 4, kc = (c & 15) * 8;
      const u16* src = QKV + (size_t)(cg_ * 64 + row) * 1536 + h * 128 + kc;
      stg[i] = *(const u32x4*)(src + 512);
      stg[2 + i] = *(const u32x4*)src;
    }
    const int row = tidx >> 3, c8 = (tidx & 7) * 8;
    stg[4] = *(const u32x4*)(TINV + (size_t)itd * 4096 + row * 64 + c8);
    stg[5] = *(const u32x4*)(INTRA + (size_t)itd * 4096 + row * 64 + c8);
  };
  auto write_stage = [&]() {
#pragma unroll
    for (int i = 0; i < 2; i++) {
      const int c = tidx + i * 512, row = c >> 4, kc = (c & 15) * 8;
      *(u32x4*)(sk + row * 136 + kc) = stg[i];
      *(u32x4*)(sq + row * 136 + kc) = stg[2 + i];
    }
    const int row = tidx >> 3, c8 = (tidx & 7) * 8;
    *(u32x4*)(sT + row * 72 + c8) = stg[4];
    *(u32x4*)(sI + row * 72 + c8) = stg[5];
  };
  u16 vv[2][4];
  float4 eg, ek;
  float egl;
  auto load_small = [&](int step) {
    const int cg_ = chunk_of(step);
    const int t0 = cg_ * 64;
    const int itd = (cg_ * 4 + h) * 2 + d;
#pragma unroll
    for (int vt = 0; vt < 2; vt++)
#pragma unroll
      for (int jj = 0; jj < 4; jj++)
        vv[vt][jj] = QKV[(size_t)(t0 + 16 * w + fq * 4 + jj) * 1536 + 1024 + vbase + vt * 16 + fr];
    eg = *(const float4*)(EG + (size_t)itd * 64 + 16 * w + fq * 4);
    ek = *(const float4*)(EKD + (size_t)itd * 64 + 16 * w + fq * 4);
    egl = EGLB[(size_t)itd * 64 + lane];
  };
#define RAW_BARRIER()                                        \
  do {                                                       \
    __builtin_amdgcn_sched_barrier(0);                       \
    asm volatile("s_waitcnt lgkmcnt(0)" ::: "memory");       \
    __builtin_amdgcn_s_barrier();                            \
    asm volatile("" ::: "memory");                           \
    __builtin_amdgcn_sched_barrier(0);                       \
  } while (0)
  load_stage(0);
  load_small(0);
  __syncthreads();

  for (int step = 0; step < nch; step++) {
    const int t0 = chunk_of(step) * 64;
    write_stage();
#pragma unroll
    for (int kt = 0; kt < 2; kt++)
#pragma unroll
      for (int vt = 0; vt < 2; vt++)
        *(uint2*)(ST + (vt * 16 + fr) * 136 + 32 * w + kt * 16 + fq * 4) =
            make_uint2(pack2(S[kt][vt][0], S[kt][vt][1]), pack2(S[kt][vt][2], S[kt][vt][3]));
    load_stage(step + 1);
    RAW_BARRIER();
    f32x4 oq[2];
    {
      bf16x8 ak[4], aq[4];
#pragma unroll
      for (int ks = 0; ks < 4; ks++) {
        ak[ks] = *(const bf16x8*)(sk + (16 * w + fr) * 136 + ks * 32 + fq * 8);
        aq[ks] = *(const bf16x8*)(sq + (16 * w + fr) * 136 + ks * 32 + fq * 8);
      }
      const float egv[4] = {eg.x, eg.y, eg.z, eg.w};
#pragma unroll
      for (int vt = 0; vt < 2; vt++) {
        f32x4 ksa = {0.f, 0.f, 0.f, 0.f}, qsa = {0.f, 0.f, 0.f, 0.f};
#pragma unroll
        for (int ks = 0; ks < 4; ks++) {
          bf16x8 b = *(const bf16x8*)(ST + (vt * 16 + fr) * 136 + ks * 32 + fq * 8);
          ksa = __builtin_amdgcn_mfma_f32_16x16x32_bf16(ak[ks], b, ksa, 0, 0, 0);
          qsa = __builtin_amdgcn_mfma_f32_16x16x32_bf16(aq[ks], b, qsa, 0, 0, 0);
        }
        float r[4];
#pragma unroll
        for (int jj = 0; jj < 4; jj++) {
          r[jj] = bf2f(vv[vt][jj]) - egv[jj] * ksa[jj];
          oq[vt][jj] = egv[jj] * QSCALE * qsa[jj];
        }
        *(uint2*)(RT + (vt * 16 + fr) * 72 + 16 * w + fq * 4) = make_uint2(pack2(r[0], r[1]), pack2(r[2], r[3]));
      }
    }
    const float4 ek_c = ek;
    const float egl_c = egl;
    load_small(step + 1);
    RAW_BARRIER();
    {
      bf16x8 aT[2];
#pragma unroll
      for (int js = 0; js < 2; js++) aT[js] = *(const bf16x8*)(sT + (16 * w + fr) * 72 + js * 32 + fq * 8);
      const float ekv[4] = {ek_c.x, ek_c.y, ek_c.z, ek_c.w};
#pragma unroll
      for (int vt = 0; vt < 2; vt++) {
        f32x4 vn = {0.f, 0.f, 0.f, 0.f};
#pragma unroll
        for (int js = 0; js < 2; js++) {
          bf16x8 b = *(const bf16x8*)(RT + (vt * 16 + fr) * 72 + js * 32 + fq * 8);
          vn = __builtin_amdgcn_mfma_f32_16x16x32_bf16(aT[js], b, vn, 0, 0, 0);
        }
        *(uint2*)(VNT + (vt * 16 + fr) * 72 + 16 * w + fq * 4) = make_uint2(pack2(vn[0], vn[1]), pack2(vn[2], vn[3]));
        *(uint2*)(VNST + (vt * 16 + fr) * 72 + 16 * w + fq * 4) =
            make_uint2(pack2(vn[0] * ekv[0], vn[1] * ekv[1]), pack2(vn[2] * ekv[2], vn[3] * ekv[3]));
      }
    }
    RAW_BARRIER();
    {
      bf16x8 aI[2], aK[2][2];
#pragma unroll
      for (int js = 0; js < 2; js++) {
        aI[js] = *(const bf16x8*)(sI + (16 * w + fr) * 72 + js * 32 + fq * 8);
#pragma unroll
        for (int kt = 0; kt < 2; kt++) {
          const u16* kp = sk + (js * 32 + fq * 8) * 136 + 32 * w + kt * 16 + fr;
          bf16x8 f;
#pragma unroll
          for (int j = 0; j < 8; j++) f[j] = (short)kp[j * 136];
          aK[kt][js] = f;
        }
      }
#pragma unroll
      for (int vt = 0; vt < 2; vt++) {
        bf16x8 bv[2], bs[2];
#pragma unroll
        for (int js = 0; js < 2; js++) {
          bv[js] = *(const bf16x8*)(VNT + (vt * 16 + fr) * 72 + js * 32 + fq * 8);
          bs[js] = *(const bf16x8*)(VNST + (vt * 16 + fr) * 72 + js * 32 + fq * 8);
        }
#pragma unroll
        for (int js = 0; js < 2; js++) oq[vt] = __builtin_amdgcn_mfma_f32_16x16x32_bf16(aI[js], bv[js], oq[vt], 0, 0, 0);
#pragma unroll
        for (int kt = 0; kt < 2; kt++) {
          f32x4 sv = S[kt][vt];
          sv[0] *= egl_c; sv[1] *= egl_c; sv[2] *= egl_c; sv[3] *= egl_c;
#pragma unroll
          for (int js = 0; js < 2; js++) sv = __builtin_amdgcn_mfma_f32_16x16x32_bf16(aK[kt][js], bs[js], sv, 0, 0, 0);
          S[kt][vt] = sv;
        }
      }
    }
#pragma unroll
    for (int vt = 0; vt < 2; vt++)
#pragma unroll
      for (int jj = 0; jj < 4; jj++) RT[(16 * w + fq * 4 + jj) * 72 + vt * 16 + fr] = f2bf(oq[vt][jj]);
    RAW_BARRIER();
    {
      const int row = tid >> 2, cc8 = (tid & 3) * 8;
      *(uint4*)(OD + (size_t)(t0 + row) * 512 + vbase + cc8) = *(const uint4*)(RT + row * 72 + cc8);
    }
  }
#undef RAW_BARRIER
  if (!lat) {
    float* so = p.out + (size_t)NT * D + (size_t)((sb * 2 + d) * 4 + h) * 16384;
#pragma unroll
    for (int kt = 0; kt < 2; kt++)
#pragma unroll
      for (int vt = 0; vt < 2; vt++)
#pragma unroll
        for (int jj = 0; jj < 4; jj++)
          so[(32 * w + kt * 16 + fq * 4 + jj) * 128 + voff + vt * 16 + fr] = S[kt][vt][jj];
  }
  __syncthreads();
}

__device__ void phase_scan(const Params& p, char* smem) {
  static_assert((SCAN_SHARED_U16 + 2 * SCAN_LDS_U16) * 2 <= SMEM_BYTES - 16, "scan LDS");
  for (int it = blockIdx.x; it < 384; it += gridDim.x) {
    int chain, vq;
    if (it < 128) { chain = it & 63; vq = it >> 6; }
    else { chain = 64 + ((it - 128) >> 1); vq = (it - 128) & 1; }
    scan_chain(p, chain, vq, smem);
  }
  if (gridDim.x > 128) {
    if (blockIdx.x >= 128) {
      pool_linear(p, smem, blockIdx.x - 128, gridDim.x - 128);
      deferred_weight_prep(p, smem, blockIdx.x - 128, gridDim.x - 128);
    }
  } else {
    pool_linear(p, smem, blockIdx.x, gridDim.x);
    deferred_weight_prep(p, smem, blockIdx.x, gridDim.x);
  }
}

__device__ void phase_ya(const Params& p) {
  const int tidx = opaque_tid();
  const int lane = tidx & 63;
  const int nwb = blockDim.x >> 6;
  const int gw = blockIdx.x * nwb + (tidx >> 6), nw = gridDim.x * nwb;
  const u16* OF = (const u16*)(p.ws + OFF_OF);
  const u16* OB = (const u16*)(p.ws + OFF_OB);
  const u16* Pz = (const u16*)(p.ws + OFF_PZ);
  u16* YA = (u16*)(p.ws + OFF_YA);
  const int cl = lane & 15;
  float gn[8];
#pragma unroll
  for (int j = 0; j < 8; j++) gn[j] = p.g_onorm[cl * 8 + j];
  for (int tb = gw; tb < NT; tb += 2 * nw) {
    uint4 ua[2], ub[2], uz[2];
#pragma unroll
    for (int u = 0; u < 2; u++) {
      const int t = min(tb + u * nw, NT - 1);
      const size_t off = (size_t)t * 512 + lane * 8;
      ua[u] = *(const uint4*)(OF + off);
      ub[u] = *(const uint4*)(OB + off);
      uz[u] = *(const uint4*)(Pz + off);
    }
#pragma unroll
    for (int u = 0; u < 2; u++) {
      const int t = tb + u * nw;
      float a[8], b[8], z[8];
      unpack8(ua[u], a);
      unpack8(ub[u], b);
      unpack8(uz[u], z);
      float ss = 0.f;
#pragma unroll
      for (int j = 0; j < 8; j++) { a[j] += b[j]; ss += a[j] * a[j]; }
      ss += __int_as_float(__builtin_amdgcn_update_dpp(0, __float_as_int(ss), 0xB1, 0xF, 0xF, false));
      ss += __int_as_float(__builtin_amdgcn_update_dpp(0, __float_as_int(ss), 0x4E, 0xF, 0xF, false));
      ss += __int_as_float(__builtin_amdgcn_update_dpp(0, __float_as_int(ss), 0x124, 0xF, 0xF, false));
      ss += __int_as_float(__builtin_amdgcn_update_dpp(0, __float_as_int(ss), 0x128, 0xF, 0xF, false));
      const float rstd = rsqrtf(ss * (1.f / 128.f) + EPS);
      float y[8];
#pragma unroll
      for (int j = 0; j < 8; j++) y[j] = a[j] * rstd * gn[j] * siluf_(z[j]);
      if (t < NT)
        *(uint4*)(YA + (size_t)t * 512 + lane * 8) =
            make_uint4(pack2(y[0], y[1]), pack2(y[2], y[3]), pack2(y[4], y[5]), pack2(y[6], y[7]));
    }
  }
}

__device__ void phase_merge(const Params& p, char* smem) {
  const u16* YA = (const u16*)(p.ws + OFF_YA);
  const u16* YB = (const u16*)(p.ws + OFF_YB);
  const u16* WA = (const u16*)(p.ws + OFF_WT_A);
  const u16* WB = (const u16*)(p.ws + OFF_WT_B);
  const u16* Pgate = (const u16*)p.out;
  u16* MG = (u16*)(p.ws + OFF_MG);
  TILE_COORDS
  for_tiles(128, 4, [&](int m, int n) {
    f32x4 acc[5][4];
    zero_acc(acc);
    gemm_tile_acc(YA + (size_t)m * 160 * 512, 512, WA + (size_t)n * 256 * 512, 512, 512, smem, acc);
#pragma unroll
    for (int mi = 0; mi < 5; mi++) {
      const int row = m * 160 + wr * 80 + mi * 16 + fr;
      const int colb = n * 256 + wc * 64 + fq * 16;
      float g[16];
      load16_bf16(Pgate + (size_t)row * 2048 + colb, g);
      f32x4 a[4];
#pragma unroll
      for (int ni = 0; ni < 4; ni++) {
        a[ni] = acc[mi][ni];
        a[ni][0] *= g[ni * 4 + 0]; a[ni][1] *= g[ni * 4 + 1]; a[ni][2] *= g[ni * 4 + 2]; a[ni][3] *= g[ni * 4 + 3];
      }
      store16_bf16(MG + (size_t)row * 1024 + colb, a);
    }
  });
  for_tiles(128, 4, [&](int m, int n) {
    f32x4 acc[5][4];
    zero_acc(acc);
    gemm_tile_acc(YB + (size_t)m * 160 * 512, 512, WB + (size_t)n * 256 * 512, 512, 512, smem, acc);
#pragma unroll
    for (int mi = 0; mi < 5; mi++) {
      const int row = m * 160 + wr * 80 + mi * 16 + fr;
      const int colb = n * 256 + wc * 64 + fq * 16;
      float g[16], mm[16];
      load16_bf16(Pgate + (size_t)row * 2048 + 1024 + colb, g);
      load16_bf16(MG + (size_t)row * 1024 + colb, mm);
      f32x4 a[4];
#pragma unroll
      for (int ni = 0; ni < 4; ni++) {
        a[ni] = acc[mi][ni];
        a[ni][0] = mm[ni * 4 + 0] + a[ni][0] * g[ni * 4 + 0]; a[ni][1] = mm[ni * 4 + 1] + a[ni][1] * g[ni * 4 + 1];
        a[ni][2] = mm[ni * 4 + 2] + a[ni][2] * g[ni * 4 + 2]; a[ni][3] = mm[ni * 4 + 3] + a[ni][3] * g[ni * 4 + 3];
      }
      store16_bf16(MG + (size_t)row * 1024 + colb, a);
    }
  });
}

template <int lda, int K>
__device__ void phase_gemm_f32(const u16* A, const u16* Bt, u16* C, char* smem) {
  TILE_COORDS
  for_tiles(128, 4, [&](int m, int n) {
    f32x4 acc[5][4];
    zero_acc(acc);
    gemm_tile_acc(A + (size_t)m * 160 * lda, lda, Bt + (size_t)n * 256 * K, K, K, smem, acc);
#pragma unroll
    for (int mi = 0; mi < 5; mi++) {
      const int row = m * 160 + wr * 80 + mi * 16 + fr;
      store16_bf16(C + (size_t)row * 1024 + n * 256 + wc * 64 + fq * 16, acc[mi]);
    }
  });
}

__device__ __forceinline__ float4 bf4(const uint2& u) { return make_float4(lo2f(u.x), hi2f(u.x), lo2f(u.y), hi2f(u.y)); }
__device__ void phase_mid(const Params& p) {
  const int tidx = opaque_tid();
  const int lane = tidx & 63;
  const int nwb = blockDim.x >> 6;
  const int gw = blockIdx.x * nwb + (tidx >> 6), nw = gridDim.x * nwb;
  const float* MOD = (const float*)(p.ws + OFF_MOD);
  const u16* T1 = (const u16*)(p.ws + OFF_T1);
  u16* X1 = (u16*)(p.ws + OFF_X1);
  u16* H2 = (u16*)(p.ws + OFF_H2);
  for (int tb = gw; tb < NT; tb += 2 * nw) {
    uint2 tv[2][4];
    float4 xv[2][4];
#pragma unroll
    for (int u = 0; u < 2; u++) {
      const int t = min(tb + u * nw, NT - 1);
      const float4* x = (const float4*)xrow(p, t);
      const uint2* tr = (const uint2*)(T1 + (size_t)t * D);
#pragma unroll
      for (int i = 0; i < 4; i++) {
        tv[u][i] = tr[lane + i * 64];
        xv[u][i] = x[lane + i * 64];
      }
    }
#pragma unroll
    for (int u = 0; u < 2; u++) {
      const int t = tb + u * nw;
      if (t >= NT) continue;
      const float* mod = MOD + cvof(t) * 6144;
      float4 v[4];
      float ss = 0.f;
#pragma unroll
      for (int i = 0; i < 4; i++) { v[i] = bf4(tv[u][i]); ss += sq4(v[i]); }
      ss = wave_sum(ss);
      const float rs1 = rsqrtf(ss * (1.f / 1024.f) + EPS);
      float s2 = 0.f;
      uint32_t xp[4][2];
#pragma unroll
      for (int i = 0; i < 4; i++) {
        const int col = (lane + i * 64) * 4;
        const float4 g = *(const float4*)(p.g_post_mix + col);
        const float4 gt = *(const float4*)(mod + 2048 + col);
        xv[u][i].x += gt.x * (v[i].x * rs1 * g.x);
        xv[u][i].y += gt.y * (v[i].y * rs1 * g.y);
        xv[u][i].z += gt.z * (v[i].z * rs1 * g.z);
        xv[u][i].w += gt.w * (v[i].w * rs1 * g.w);
        s2 += sq4(xv[u][i]);
        xp[i][0] = pack2(xv[u][i].x, xv[u][i].y);
        xp[i][1] = pack2(xv[u][i].z, xv[u][i].w);
      }
      store_pair16(X1 + (size_t)t * D, lane, 0, xp[0][0], xp[0][1], xp[1][0], xp[1][1]);
      store_pair16(X1 + (size_t)t * D, lane, 2, xp[2][0], xp[2][1], xp[3][0], xp[3][1]);
      s2 = wave_sum(s2);
      const float rs2 = rsqrtf(s2 * (1.f / 1024.f) + EPS);
#pragma unroll
      for (int i = 0; i < 4; i++) {
        const int col = (lane + i * 64) * 4;
        const float4 g = *(const float4*)(p.g_pre_ffn + col);
        const float4 sh = *(const float4*)(mod + 3072 + col);
        const float4 sc = *(const float4*)(mod + 4096 + col);
        float h0 = xv[u][i].x * rs2 * g.x * (1.f + sc.x) + sh.x;
        float h1 = xv[u][i].y * rs2 * g.y * (1.f + sc.y) + sh.y;
        float h2 = xv[u][i].z * rs2 * g.z * (1.f + sc.z) + sh.z;
        float h3 = xv[u][i].w * rs2 * g.w * (1.f + sc.w) + sh.w;
        xp[i][0] = pack2(h0, h1);
        xp[i][1] = pack2(h2, h3);
      }
      store_pair16(H2 + (size_t)t * D, lane, 0, xp[0][0], xp[0][1], xp[1][0], xp[1][1]);
      store_pair16(H2 + (size_t)t * D, lane, 2, xp[2][0], xp[2][1], xp[3][0], xp[3][1]);
    }
  }
}

__device__ void phase_up(const Params& p, char* smem) {
  const u16* H2 = (const u16*)(p.ws + OFF_H2);
  const u16* WT = (const u16*)(p.ws + OFF_WT_UP);
  u16* ACT = (u16*)(p.ws + OFF_ACT);
  TILE_COORDS
  for_tiles(80, 22, [&](int m, int n) {
    f32x4 acc[8][4];
    zero_acc(acc);
    gemm_tile_acc(H2 + (size_t)m * 256 * 1024, 1024, WT + (size_t)n * 256 * 1024, 1024, 1024, smem, acc);
    const int jb = n * 128 + wc * 32;
#pragma unroll
    for (int mi = 0; mi < 8; mi++) {
      const int row = m * 256 + wr * 128 + mi * 16 + fr;
      const f32x4 g0 = acc[mi][0], g1 = acc[mi][1], u0 = acc[mi][2], u1 = acc[mi][3];
      *(uint4*)(ACT + (size_t)row * DFF + jb + fq * 8) =
          make_uint4(pack2(siluf_(g0[0]) * u0[0], siluf_(g0[1]) * u0[1]), pack2(siluf_(g0[2]) * u0[2], siluf_(g0[3]) * u0[3]),
                     pack2(siluf_(g1[0]) * u1[0], siluf_(g1[1]) * u1[1]), pack2(siluf_(g1[2]) * u1[2], siluf_(g1[3]) * u1[3]));
    }
  });
}

__device__ void phase_final(const Params& p) {
  const int tidx = opaque_tid();
  const int lane = tidx & 63;
  const int nwb = blockDim.x >> 6;
  const int gw = blockIdx.x * nwb + (tidx >> 6), nw = gridDim.x * nwb;
  const float* MOD = (const float*)(p.ws + OFF_MOD);
  const u16* T2 = (const u16*)(p.ws + OFF_T2);
  const u16* X1 = (const u16*)(p.ws + OFF_X1);
  for (int tb = gw; tb < NT; tb += 4 * nw) {
    uint2 tv[4][4], xr[4][4];
#pragma unroll
    for (int u = 0; u < 4; u++) {
      const int t = min(tb + u * nw, NT - 1);
      const uint2* tr = (const uint2*)(T2 + (size_t)t * D);
      const uint2* xp = (const uint2*)(X1 + (size_t)t * D);
#pragma unroll
      for (int i = 0; i < 4; i++) {
        tv[u][i] = tr[lane + i * 64];
        xr[u][i] = xp[lane + i * 64];
      }
    }
#pragma unroll
    for (int u = 0; u < 4; u++) {
      const int t = tb + u * nw;
      if (t >= NT) continue;
      const float* mod = MOD + cvof(t) * 6144;
      float4 v[4];
      float ss = 0.f;
#pragma unroll
      for (int i = 0; i < 4; i++) { v[i] = bf4(tv[u][i]); ss += sq4(v[i]); }
      ss = wave_sum(ss);
      const float rs = rsqrtf(ss * (1.f / 1024.f) + EPS);
#pragma unroll
      for (int i = 0; i < 4; i++) {
        const int col = (lane + i * 64) * 4;
        const float4 g = *(const float4*)(p.g_post_ffn + col);
        const float4 gt = *(const float4*)(mod + 5120 + col);
        float4 r = bf4(xr[u][i]);
        r.x += gt.x * (v[i].x * rs * g.x);
        r.y += gt.y * (v[i].y * rs * g.y);
        r.z += gt.z * (v[i].z * rs * g.z);
        r.w += gt.w * (v[i].w * rs * g.w);
        *(float4*)(p.out + (size_t)t * D + col) = r;
      }
    }
  }
}

#define XB_TMO      128
#define XB_XCNT(j)  (256  + 64 * (j))
#define XB_XSUB(j)  (1280 + 64 * (j))
#define XB_XGEN(j)  (2304 + 64 * (j))
#define XB_TOP      3328
#define XB_TOPGEN   3392
#define XCD_BAR_WORDS 3456
#define XB_SPIN_CAP (1u << 18)
#define LAS __attribute__((address_space(3)))
__device__ __forceinline__ unsigned xb_ld(unsigned* p) { return __hip_atomic_load(p, __ATOMIC_RELAXED, __HIP_MEMORY_SCOPE_AGENT); }
__device__ __forceinline__ unsigned xb_add(unsigned* p, unsigned v) { return __hip_atomic_fetch_add(p, v, __ATOMIC_RELAXED, __HIP_MEMORY_SCOPE_AGENT); }
__device__ __forceinline__ unsigned xb_xcc_id() { return (unsigned)__builtin_amdgcn_s_getreg((3 << 11) | 20) & 0xFu; }
#define XB_SPIN(cond, bar) do { unsigned _sp = 0; while (cond) { __builtin_amdgcn_s_sleep(1); \
    if ((++_sp & 255u) == 0u) { if (xb_ld(&(bar)[XB_TMO])) break; if (_sp > XB_SPIN_CAP) { atomicAdd(&(bar)[XB_TMO], 1u); break; } } } } while (0)
struct XcdBarrier {
  unsigned* bar; unsigned x;
  volatile LAS unsigned* st;
};
__device__ __forceinline__ XcdBarrier xcd_barrier_post(unsigned* bar, volatile LAS unsigned* st) {
  XcdBarrier b; b.bar = bar; b.x = xb_xcc_id(); b.st = st;
  if (threadIdx.x == 0) (void)xb_add(&bar[XB_XCNT(b.x)], 1u);
  return b;
}
__device__ __forceinline__ void xcd_barrier_complete(unsigned* bar, unsigned x, unsigned& nloc, unsigned& nx) {
  const unsigned G = gridDim.x * gridDim.y * gridDim.z;
  unsigned sum, cnt, mine, sp = 0u;
  for (;;) {
    sum = 0u; cnt = 0u; mine = 0u;
#pragma unroll
    for (unsigned j = 0; j < 16; ++j) { const unsigned c = xb_ld(&bar[XB_XCNT(j)]); sum += c; cnt += (c > 0u) ? 1u : 0u; mine = (j == x) ? c : mine; }
    if (sum == G) break;
    __builtin_amdgcn_s_sleep(1);
    if ((++sp & 255u) == 0u) { if (xb_ld(&bar[XB_TMO])) break; if (sp > XB_SPIN_CAP) { atomicAdd(&bar[XB_TMO], 1u); break; } }
  }
  nloc = mine > 0u ? mine : 1u; nx = cnt > 0u ? cnt : 1u;
}
__device__ __forceinline__ void xcd_barrier(unsigned* bar_, char* smem_) {
  asm volatile("s_waitcnt vmcnt(0)" ::: "memory");
  __syncthreads();
  if (threadIdx.x == 0) {
    XcdBarrier b; b.bar = bar_; b.x = xb_xcc_id(); b.st = (volatile LAS unsigned*)(smem_ + SMEM_BYTES - 16);
    unsigned* bar = b.bar;
    __builtin_amdgcn_s_waitcnt(0);
    unsigned nloc = b.st[0], nx = b.st[1];
    if (nloc == 0u) { xcd_barrier_complete(bar, b.x, nloc, nx); b.st[0] = nloc; b.st[1] = nx; }
    const unsigned old = xb_add(&bar[XB_XSUB(b.x)], 1u);
    const unsigned gen = old / nloc;
    if (old + 1u == (gen + 1u) * nloc) {
      __builtin_amdgcn_fence(__ATOMIC_RELEASE, "agent");
      asm volatile("s_waitcnt vmcnt(0)" ::: "memory");
      const unsigned og = xb_add(&bar[XB_TOP], 1u);
      const unsigned tg = og / nx;
      if (og + 1u == (tg + 1u) * nx) xb_add(&bar[XB_TOPGEN], 1u);
      else XB_SPIN(xb_ld(&bar[XB_TOPGEN]) == tg, bar);
      __builtin_amdgcn_fence(__ATOMIC_ACQUIRE, "agent");
      xb_add(&bar[XB_XGEN(b.x)], 1u);
      asm volatile("s_waitcnt vmcnt(0)" ::: "memory");
    } else {
      XB_SPIN(xb_ld(&bar[XB_XGEN(b.x)]) == gen, bar);
      __builtin_amdgcn_fence(__ATOMIC_ACQUIRE, "agent");
      asm volatile("s_waitcnt vmcnt(0)" ::: "memory");
    }
  }
  __syncthreads();
}

template <int PH>
__device__ __forceinline__ void run_phase(const Params& p, char* smem) {
  if (PH == 0) phase_prep(p, smem);
  else if (PH == 1) phase_h1(p);
  else if (PH == 2) phase_gemm_in(p, smem);
  else if (PH == 3) phase_conv_pool(p);
  else if (PH == 4) phase_pre(p, smem);
  else if (PH == 5) phase_scan(p, smem);
  else if (PH == 6) phase_ya(p);
  else if (PH == 7) phase_merge(p, smem);
  else if (PH == 8) phase_gemm_f32<1024, 1024>((const u16*)(p.ws + OFF_MG), (const u16*)(p.ws + OFF_WT_O), (u16*)(p.ws + OFF_T1), smem);
  else if (PH == 9) phase_mid(p);
  else if (PH == 10) phase_up(p, smem);
  else if (PH == 11) phase_gemm_f32<DFF, DFF>((const u16*)(p.ws + OFF_ACT), (const u16*)(p.ws + OFF_WT_DOWN), (u16*)(p.ws + OFF_T2), smem);
  else if (PH == 12) phase_final(p);
}

#if MODE_MEGA
#ifndef PROBE_MASK
#define PROBE_MASK 0
#endif
#define XBAR() xcd_barrier((unsigned*)(p.ws + OFF_BAR), smem)
#define RUN(i) _Pragma("nounroll") for (int rep_ = 0; rep_ < ((PROBE_MASK >> i) & 1) + 1; rep_++) { run_phase<i>(p, smem); XBAR(); }
__global__ void __launch_bounds__(512, 2) mega_kernel(Params p) {
  __shared__ __attribute__((aligned(1024))) char smem[SMEM_BYTES];
  cg::grid_group grid = cg::this_grid();
  unsigned* bar = (unsigned*)(p.ws + OFF_BAR);
  volatile LAS unsigned* st = (volatile LAS unsigned*)(smem + SMEM_BYTES - 16);
  if (threadIdx.x == 0) { st[0] = 0u; st[1] = 0u; }
  (void)xcd_barrier_post(bar, st);
  if (p.ws == nullptr) grid.sync();
  RUN(0)
  RUN(1) RUN(2) RUN(3) RUN(4) RUN(5) RUN(6) RUN(7) RUN(8) RUN(9) RUN(10) RUN(11)
  run_phase<12>(p, smem);
}
#else
template <int PH>
__global__ void __launch_bounds__(512, 2) phase_kernel(Params p) {
  __shared__ __attribute__((aligned(1024))) char smem[SMEM_BYTES];
  run_phase<PH>(p, smem);
}
#endif

extern "C" void kernel_launch(void* const* d_in, const int* in_sizes, int n_in, void* d_out, int out_size, void* d_ws,
                              size_t ws_size, hipStream_t stream) {
  Params p{};
  const float** pp = (const float**)&p;
  for (int i = 0; i < 23; i++) pp[i] = (const float*)d_in[i];
  p.out = (float*)d_out;
  p.ws = (unsigned char*)d_ws;
#if MODE_MEGA
  static int grid_blocks = 0;
  if (!grid_blocks) {
    int dev = 0, cus = 0, per_cu = 0;
    hipGetDevice(&dev);
    hipDeviceGetAttribute(&cus, hipDeviceAttributeMultiprocessorCount, dev);
    hipOccupancyMaxActiveBlocksPerMultiprocessor(&per_cu, mega_kernel, 512, 0);
    if (per_cu > 1) per_cu = 1;
    if (per_cu < 1) per_cu = 1;
    grid_blocks = cus * per_cu;
  }
  hipMemsetAsync((unsigned char*)d_ws + OFF_BAR, 0, 16384, stream);
  void* args[] = {&p};
  hipError_t e = hipLaunchCooperativeKernel((void*)mega_kernel, dim3(grid_blocks), dim3(512), args, 0, stream);
  if (e != hipSuccess) fprintf(stderr, "cooperative launch failed: %s (grid %d)\n", hipGetErrorString(e), grid_blocks);
#else
  const int G = 256;
  phase_kernel<0><<<G, 512, 0, stream>>>(p);
  phase_kernel<1><<<G, 512, 0, stream>>>(p);
  phase_kernel<2><<<G, 512, 0, stream>>>(p);
  phase_kernel<3><<<G, 512, 0, stream>>>(p);
  phase_kernel<4><<<G, 512, 0, stream>>>(p);
  phase_kernel<5><<<G, 512, 0, stream>>>(p);
  phase_kernel<6><<<G, 512, 0, stream>>>(p);
  phase_kernel<7><<<G, 512, 0, stream>>>(p);
  phase_kernel<8><<<G, 512, 0, stream>>>(p);
  phase_kernel<9><<<G, 512, 0, stream>>>(p);
  phase_kernel<10><<<G, 512, 0, stream>>>(p);
  phase_kernel<11><<<G, 512, 0, stream>>>(p);
  phase_kernel<12><<<G, 512, 0, stream>>>(p);
#endif
}
```

```cpp
#include <hip/hip_runtime.h>
#include <hip/hip_cooperative_groups.h>
#include <stdint.h>
#include <cstdio>
namespace cg = cooperative_groups;

#ifndef MODE_MEGA
#define MODE_MEGA 1
#endif

typedef __attribute__((ext_vector_type(8))) short bf16x8;
typedef __attribute__((ext_vector_type(4))) float f32x4;
typedef unsigned short u16;
typedef __attribute__((ext_vector_type(4))) unsigned int u32x4;
typedef __attribute__((ext_vector_type(2))) unsigned int u32x2;

constexpr int D = 1024;
constexpr int NT = 20480;
constexpr int NCTX = 4096;
constexpr int DFF = 2816;
constexpr float EPS = 1e-6f;
constexpr float QSCALE = 0.08838834764831845f;

constexpr size_t MiB = 1048576;
constexpr size_t OFF_WT_IN = 0;
constexpr size_t OFF_WT_UP = OFF_WT_IN + (size_t)4864 * 1024 * 2;
constexpr size_t OFF_WT_DOWN = OFF_WT_UP + (size_t)5632 * 1024 * 2;
constexpr size_t OFF_WT_O = OFF_WT_DOWN + (size_t)1024 * 2816 * 2;
constexpr size_t OFF_WT_A = OFF_WT_O + (size_t)1024 * 1024 * 2;
constexpr size_t OFF_WT_B = OFF_WT_A + (size_t)1024 * 512 * 2;
constexpr size_t OFF_WT_POOL = OFF_WT_B + (size_t)1024 * 512 * 2;
constexpr size_t OFF_WT_END = OFF_WT_POOL + (size_t)512 * 512 * 2;
static_assert(OFF_WT_END <= 32 * MiB, "weights");
constexpr size_t OFF_MOD = 32 * MiB;
constexpr size_t OFF_AB = 32 * MiB + 262144;
constexpr size_t OFF_EG = 34 * MiB;
constexpr size_t OFF_BETA = OFF_EG + (size_t)2560 * 64 * 4;
constexpr size_t OFF_EKD = OFF_BETA + (size_t)2560 * 64 * 4;
constexpr size_t OFF_BAR = 36 * MiB - 16384;
constexpr size_t OFF_PROG = OFF_BAR + 3456 * 4;
constexpr size_t OFF_H1 = 36 * MiB;
constexpr size_t OFF_DP = 36 * MiB;
constexpr size_t OFF_YB = 56 * MiB;
constexpr size_t OFF_PQKV = 76 * MiB;
constexpr size_t OFF_TINV = 76 * MiB;
constexpr size_t OFF_INTRA = 96 * MiB;
constexpr size_t OFF_KT = 116 * MiB;
constexpr size_t OFF_YA = 76 * MiB;
constexpr size_t OFF_PPOOL = 136 * MiB;
constexpr size_t OFF_OF = 136 * MiB;
constexpr size_t OFF_PZ = 156 * MiB;
constexpr size_t OFF_QKV = 176 * MiB;
constexpr size_t OFF_OB = 236 * MiB;
constexpr size_t OFF_MG = 176 * MiB;
constexpr size_t OFF_T1 = 76 * MiB;
constexpr size_t OFF_H2 = 216 * MiB;
constexpr size_t OFF_ACT = 36 * MiB;
constexpr size_t OFF_T2 = 196 * MiB;
constexpr size_t OFF_X1 = 156 * MiB;

struct Params {
  const float *x_prompt, *x_sample, *state_delta, *c, *c_ctx, *w_mod, *b_mod, *g_pre_mix, *g_post_mix, *g_pre_ffn,
      *g_post_ffn, *w_in, *conv_w, *a_log, *dt_bias, *g_onorm, *w_a_proj, *w_pool, *pool_scale, *w_b_proj, *w_o, *w_up,
      *w_down;
  float* out;
  unsigned char* ws;
};

typedef __bf16 bf16x2_t __attribute__((ext_vector_type(2)));
typedef float f32x2_t __attribute__((ext_vector_type(2)));
__device__ __forceinline__ uint32_t pack2(float a, float b) {
  f32x2_t v = {a, b};
  return __builtin_bit_cast(uint32_t, __builtin_convertvector(v, bf16x2_t));
}
__device__ __forceinline__ u16 f2bf(float f) { return (u16)(pack2(f, f) & 0xffffu); }
__device__ __forceinline__ float bf2f(u16 h) { return __uint_as_float(((uint32_t)h) << 16); }
__device__ __forceinline__ float lo2f(uint32_t u) { return __uint_as_float(u << 16); }
__device__ __forceinline__ float hi2f(uint32_t u) { return __uint_as_float(u & 0xffff0000u); }
__device__ __forceinline__ void unpack8(const uint4& u, float* f) {
  f[0] = lo2f(u.x); f[1] = hi2f(u.x); f[2] = lo2f(u.y); f[3] = hi2f(u.y);
  f[4] = lo2f(u.z); f[5] = hi2f(u.z); f[6] = lo2f(u.w); f[7] = hi2f(u.w);
}
__device__ __forceinline__ float sigmoidf_(float x) { return __builtin_amdgcn_rcpf(1.f + __expf(-x)); }
__device__ __forceinline__ float siluf_(float x) { return x * __builtin_amdgcn_rcpf(1.f + __expf(-x)); }
__device__ __forceinline__ int opaque_tid() {
  int t = threadIdx.x;
  asm volatile("" : "+v"(t));
  return t;
}
__device__ __forceinline__ float wave_sum_dpp(float v) {
  int x = __float_as_int(v);
  v += __int_as_float(__builtin_amdgcn_update_dpp(0, x, 0xB1, 0xF, 0xF, false));
  x = __float_as_int(v);
  v += __int_as_float(__builtin_amdgcn_update_dpp(0, x, 0x4E, 0xF, 0xF, false));
  x = __float_as_int(v);
  v += __int_as_float(__builtin_amdgcn_update_dpp(0, x, 0x124, 0xF, 0xF, false));
  x = __float_as_int(v);
  v += __int_as_float(__builtin_amdgcn_update_dpp(0, x, 0x128, 0xF, 0xF, false));
  x = __float_as_int(v);
  v += __int_as_float(__builtin_amdgcn_update_dpp(0, x, 0x142, 0xA, 0xF, false));
  x = __float_as_int(v);
  v += __int_as_float(__builtin_amdgcn_update_dpp(0, x, 0x143, 0xC, 0xF, false));
  return __int_as_float(__builtin_amdgcn_readlane(__float_as_int(v), 63));
}
__device__ __forceinline__ void store_pair16(u16* rowp, int lane, int i0, uint32_t a0, uint32_t a1, uint32_t b0, uint32_t b1) {
  const uint32_t na0 = (uint32_t)__builtin_amdgcn_update_dpp(0, (int)a0, 0xB1, 0xF, 0xF, false);
  const uint32_t na1 = (uint32_t)__builtin_amdgcn_update_dpp(0, (int)a1, 0xB1, 0xF, 0xF, false);
  const uint32_t nb0 = (uint32_t)__builtin_amdgcn_update_dpp(0, (int)b0, 0xB1, 0xF, 0xF, false);
  const uint32_t nb1 = (uint32_t)__builtin_amdgcn_update_dpp(0, (int)b1, 0xB1, 0xF, 0xF, false);
  const bool odd = lane & 1;
  const uint4 v = odd ? make_uint4(nb0, nb1, b0, b1) : make_uint4(a0, a1, na0, na1);
  const int col = odd ? ((lane - 1) + (i0 + 1) * 64) * 4 : (lane + i0 * 64) * 4;
  *(uint4*)(rowp + col) = v;
}
__device__ __forceinline__ float wave_sum(float v) {
#pragma unroll
  for (int o = 32; o > 0; o >>= 1) v += __shfl_xor(v, o);
  return v;
}

constexpr int SMEM_BYTES = 144 * 1024;
constexpr int TILE_B = 256 * 64 * 2;
constexpr int STAGE_B = 2 * TILE_B;
typedef __attribute__((address_space(3))) unsigned lds_u32;

__device__ __forceinline__ int lds_byte(int r, int c) {
  int st = (r >> 4) * 2 + (c >> 5), ob = (r & 15) * 64 + (c & 31) * 2;
  return st * 1024 + (ob ^ (((ob >> 9) & 1) << 5));
}
__device__ __forceinline__ void stage_rc(int b, int& R, int& C) {
  int st = b >> 10, sb = b & 1023, swz = sb ^ (((sb >> 9) & 1) << 5);
  R = (st >> 1) * 16 + swz / 64;
  C = (st & 1) * 32 + (swz % 64) / 2;
}

template <int MI>
__device__ __forceinline__ void gemm_tile_acc(const u16* __restrict__ A, int lda, const u16* __restrict__ Bt, int ldb,
                                              int K, char* shm, f32x4 (&acc)[MI][4]) {
  constexpr int NCH_A = MI * 4;
  const int tid = opaque_tid(), lane = tid & 63, wid = tid >> 6, wr = wid >> 2, wc = wid & 3, fr = lane & 15, fq = lane >> 4;
  const u16* pa[4];
  const u16* pb[4];
#pragma unroll
  for (int i = 0; i < 4; i++) {
    int R, C;
    stage_rc(wid * 1024 + i * 8192 + lane * 16, R, C);
    pa[i] = A + (size_t)R * lda + C;
    pb[i] = Bt + (size_t)R * ldb + C;
  }
#define GLDS_STAGE(buf, kt)                                                                                          \
  do {                                                                                                               \
    _Pragma("unroll") for (int i = 0; i < 4; i++) {                                                                  \
      if (wid + i * 8 < NCH_A)                                                                                       \
        __builtin_amdgcn_global_load_lds((const unsigned*)(pa[i] + (kt) * 64),                                       \
                                         (lds_u32*)(shm + (buf) * STAGE_B + wid * 1024 + i * 8192), 16, 0, 0);        \
      __builtin_amdgcn_global_load_lds((const unsigned*)(pb[i] + (kt) * 64),                                         \
                                       (lds_u32*)(shm + (buf) * STAGE_B + TILE_B + wid * 1024 + i * 8192), 16, 0, 0); \
    }                                                                                                                \
  } while (0)
  const int nt = K >> 6;
  GLDS_STAGE(0, 0);
  asm volatile("s_waitcnt vmcnt(0)" ::: "memory");
  __syncthreads();
  for (int t = 0; t < nt; t++) {
    const int cur = t & 1;
    if (t + 1 < nt) GLDS_STAGE(cur ^ 1, t + 1);
    const char* sa = shm + cur * STAGE_B;
    const char* sb = sa + TILE_B;
#pragma unroll
    for (int ks = 0; ks < 2; ks++) {
      bf16x8 At[MI], Bf[4];
#pragma unroll
      for (int m = 0; m < MI; m++) At[m] = *(const bf16x8*)(sa + lds_byte(wr * (MI * 16) + m * 16 + fr, ks * 32 + fq * 8));
#pragma unroll
      for (int n = 0; n < 4; n++) Bf[n] = *(const bf16x8*)(sb + lds_byte(wc * 64 + n * 16 + fr, ks * 32 + fq * 8));
      __builtin_amdgcn_iglp_opt(0);
      __builtin_amdgcn_s_setprio(1);
#pragma unroll
      for (int m = 0; m < MI; m++)
#pragma unroll
        for (int n = 0; n < 4; n++)
          acc[m][n] = __builtin_amdgcn_mfma_f32_16x16x32_bf16(Bf[n], At[m], acc[m][n], 0, 0, 0);
      __builtin_amdgcn_s_setprio(0);
    }
    asm volatile("s_waitcnt vmcnt(0)" ::: "memory");
    __syncthreads();
  }
#undef GLDS_STAGE
}

template <int MI>
__device__ __forceinline__ void zero_acc(f32x4 (&acc)[MI][4]) {
#pragma unroll
  for (int i = 0; i < MI; i++)
#pragma unroll
    for (int j = 0; j < 4; j++) acc[i][j] = f32x4{0.f, 0.f, 0.f, 0.f};
}

__device__ __forceinline__ void store16_bf16(u16* dst, const f32x4 (&a)[4]) {
  *(uint4*)dst = make_uint4(pack2(a[0][0], a[0][1]), pack2(a[0][2], a[0][3]), pack2(a[1][0], a[1][1]), pack2(a[1][2], a[1][3]));
  *(uint4*)(dst + 8) = make_uint4(pack2(a[2][0], a[2][1]), pack2(a[2][2], a[2][3]), pack2(a[3][0], a[3][1]), pack2(a[3][2], a[3][3]));
}
__device__ __forceinline__ void load16_bf16(const u16* src, float (&g)[16]) {
  float lo[8], hi[8];
  unpack8(*(const uint4*)src, lo);
  unpack8(*(const uint4*)(src + 8), hi);
#pragma unroll
  for (int i = 0; i < 8; i++) { g[i] = lo[i]; g[8 + i] = hi[i]; }
}

template <class F>
__device__ __forceinline__ void for_tiles(int nM, int nN, F f, int bid = blockIdx.x, int G = gridDim.x) {
  const int nT = nM * nN;
  const int GM = 8;
  const int gfull = GM * nN;
  const bool sw = (G & 7) == 0;
  const int per = sw ? ((nT + 7) >> 3) : nT;
  const int start = sw ? (bid >> 3) : bid;
  const int stride = sw ? (G >> 3) : G;
  const int base = sw ? (bid & 7) * per : 0;
  for (int q = start; q < per; q += stride) {
    const int id = base + q;
    if (id >= nT) break;
    const int g = id / gfull, r = id - g * gfull;
    const int gsz = min(GM, nM - g * GM);
    f(g * GM + r % gsz, r / gsz);
  }
}

#define TILE_COORDS                                                                                         \
  const int tid = opaque_tid(), lane = tid & 63, w = tid >> 6, wr = w >> 2, wc = w & 3, fr = lane & 15, \
            fq = lane >> 4;                                                                                 \
  (void)tid; (void)lane; (void)w; (void)wr; (void)wc; (void)fr; (void)fq;

__device__ __forceinline__ int perm64(int c) { return (c & ~63) | (((c >> 2) & 3) << 4) | (((c >> 4) & 3) << 2) | (c & 3); }
__device__ __forceinline__ int maprow(int mode, int n) {
  if (mode == 1) {
    int r;
    if (n < 2048) r = n;
    else if (n < 2064) r = 4608 + (n - 2048);
    else if (n < 2576) r = 2048 + (n - 2064);
    else if (n < 4624) r = 2560 + (n - 2576);
    else r = n;
    return perm64(r);
  } else if (mode == 2) {
    const int up = n >= DFF;
    const int j = up ? n - DFF : n;
    const int jo = j & 31;
    return (j >> 5) * 64 + up * 32 + ((jo >> 2) & 1) * 16 + (jo >> 3) * 4 + (jo & 3);
  }
  return perm64(n);
}

struct TrDesc {
  const float* src;
  u16* dst;
  int srcN, nvalid, k0, n0, dst_ld, mode;
};

__device__ __forceinline__ TrDesc tr_decode(const Params& p, int id) {
  TrDesc d;
  d.mode = 0;
  if (id < 1216) {
    d.src = p.w_in; d.srcN = 4624; d.nvalid = 4624; d.k0 = (id & 15) * 64; d.n0 = (id >> 4) * 64;
    d.dst = (u16*)(p.ws + OFF_WT_IN); d.dst_ld = 1024; d.mode = 1;
    return d;
  }
  id -= 1216;
  if (id < 1408) {
    d.src = p.w_up; d.srcN = 5632; d.nvalid = 5632; d.k0 = (id & 15) * 64; d.n0 = (id >> 4) * 64;
    d.dst = (u16*)(p.ws + OFF_WT_UP); d.dst_ld = 1024; d.mode = 2;
    return d;
  }
  id -= 1408;
  if (id < 704) {
    d.src = p.w_down; d.srcN = 1024; d.nvalid = 1024; d.k0 = (id % 44) * 64; d.n0 = (id / 44) * 64;
    d.dst = (u16*)(p.ws + OFF_WT_DOWN); d.dst_ld = 2816;
    return d;
  }
  id -= 704;
  if (id < 256) {
    d.src = p.w_o; d.srcN = 1024; d.nvalid = 1024; d.k0 = (id & 15) * 64; d.n0 = (id >> 4) * 64;
    d.dst = (u16*)(p.ws + OFF_WT_O); d.dst_ld = 1024;
    return d;
  }
  id -= 256;
  if (id < 128) {
    d.src = p.w_a_proj; d.srcN = 1024; d.nvalid = 1024; d.k0 = (id & 7) * 64; d.n0 = (id >> 3) * 64;
    d.dst = (u16*)(p.ws + OFF_WT_A); d.dst_ld = 512;
    return d;
  }
  id -= 128;
  if (id < 128) {
    d.src = p.w_b_proj; d.srcN = 1024; d.nvalid = 1024; d.k0 = (id & 7) * 64; d.n0 = (id >> 3) * 64;
    d.dst = (u16*)(p.ws + OFF_WT_B); d.dst_ld = 512;
    return d;
  }
  id -= 128;
  {
    const int kt = id & 7, ntile = id >> 3;
    const int g = kt >> 1;
    u16* base = (u16*)(p.ws + OFF_WT_POOL);
    d.dst_ld = 512;
    if ((ntile >> 1) == g) {
      d.src = p.w_pool + g * 16384; d.srcN = 128; d.nvalid = 128; d.k0 = (kt & 1) * 64; d.n0 = (ntile & 1) * 64;
      d.dst = base + (size_t)(g * 128) * 512 + g * 128;
    } else {
      d.src = p.w_pool; d.srcN = 128; d.nvalid = 0; d.k0 = kt * 64; d.n0 = ntile * 64;
      d.dst = base;
    }
    return d;
  }
}
constexpr int N_TR_TILES = 1216 + 1408 + 704 + 256 + 128 + 128 + 64;

__device__ void tr_tile(const TrDesc& d, float* sm, int ltid) {
  const int c = ltid & 63, r4 = ltid >> 6;
  const int n = d.n0 + c;
  const bool nv = n < d.nvalid;
  float tv[16];
#pragma unroll
  for (int i = 0; i < 16; i++) tv[i] = nv ? d.src[(size_t)(d.k0 + r4 + i * 4) * d.srcN + n] : 0.f;
#pragma unroll
  for (int i = 0; i < 16; i++) sm[(r4 + i * 4) * 65 + c] = tv[i];
  __syncthreads();
  const int nr = ltid >> 2, kq = (ltid & 3) * 16;
  const int nd = maprow(d.mode, d.n0 + nr);
  uint32_t pk[8];
#pragma unroll
  for (int j = 0; j < 8; j++) pk[j] = pack2(sm[(kq + 2 * j) * 65 + nr], sm[(kq + 2 * j + 1) * 65 + nr]);
  uint4* o = (uint4*)(d.dst + (size_t)nd * d.dst_ld + d.k0 + kq);
  o[0] = make_uint4(pk[0], pk[1], pk[2], pk[3]);
  o[1] = make_uint4(pk[4], pk[5], pk[6], pk[7]);
  __syncthreads();
}

__device__ void mod_item(const Params& p, int item, float* sm) {
  const int tid = opaque_tid();
  for (int i = tid; i < 9 * 1024; i += 512) {
    int cv = i >> 10, k = i & 1023;
    float cval = (cv < 8) ? p.c[cv * 1024 + k] : p.c_ctx[k];
    sm[i] = siluf_(cval);
  }
  __syncthreads();
  const int cl = tid & 63, kg = tid >> 6;
  const int n = item * 64 + cl;
  float acc[9];
#pragma unroll
  for (int cv = 0; cv < 9; cv++) acc[cv] = 0.f;
  const float* wp = p.w_mod + (size_t)(kg * 128) * 6144 + n;
#pragma unroll 16
  for (int k = 0; k < 128; k++) {
    float wv = wp[(size_t)k * 6144];
#pragma unroll
    for (int cv = 0; cv < 9; cv++) acc[cv] += sm[cv * 1024 + kg * 128 + k] * wv;
  }
  __syncthreads();
  float* red = sm + 9 * 1024;
#pragma unroll
  for (int cv = 0; cv < 9; cv++) red[(kg * 9 + cv) * 64 + cl] = acc[cv];
  __syncthreads();
  float* MOD = (float*)(p.ws + OFF_MOD);
  for (int i = tid; i < 9 * 64; i += 512) {
    int cv = i >> 6, c2 = i & 63;
    float s = 0.f;
#pragma unroll
    for (int g = 0; g < 8; g++) s += red[(g * 9 + cv) * 64 + c2];
    MOD[cv * 6144 + item * 64 + c2] = s + p.b_mod[item * 64 + c2];
  }
  __syncthreads();
}

__device__ void phase_prep(const Params& p, char* smem) {
  float* sm = (float*)smem;
  const int tidx = opaque_tid();
  const int half = tidx >> 8, ltid = tidx & 255;
  constexpr int N_MOD_IT = 96;
  constexpr int N_EARLY = 1216 + 64;
  for (int it = blockIdx.x; it < N_MOD_IT + N_EARLY / 2; it += gridDim.x) {
    if (it < N_MOD_IT) {
      mod_item(p, it, sm);
    } else {
      int id = (it - N_MOD_IT) * 2 + half;
      if (id >= 1216) id += N_TR_TILES - 64 - 1216;
      TrDesc d = tr_decode(p, id);
      tr_tile(d, sm + half * (64 * 65), ltid);
    }
  }
}

__device__ void deferred_weight_prep(const Params& p, char* smem, int worker, int nworkers) {
  float* sm = (float*)smem;
  const int tidx = opaque_tid();
  const int half = tidx >> 8, ltid = tidx & 255;
  constexpr int N_DEF = N_TR_TILES - 64 - 1216;
  for (int it = worker; it < N_DEF / 2; it += nworkers) {
    TrDesc d = tr_decode(p, 1216 + it * 2 + half);
    tr_tile(d, sm + half * (64 * 65), ltid);
  }
}

__device__ __forceinline__ const float* xrow(const Params& p, int t) {
  return t < NCTX ? p.x_prompt + (size_t)t * D : p.x_sample + (size_t)(t - NCTX) * D;
}
__device__ __forceinline__ int cvof(int t) { return t < NCTX ? 8 : ((t - NCTX) >> 11); }
__device__ __forceinline__ float sq4(const float4& v) { return v.x * v.x + v.y * v.y + v.z * v.z + v.w * v.w; }

__device__ void phase_h1(const Params& p) {
  const int tidx = opaque_tid();
  const int lane = tidx & 63;
  const int nwb = blockDim.x >> 6;
  const int gw = blockIdx.x * nwb + (tidx >> 6), nw = gridDim.x * nwb;
  const float* MOD = (const float*)(p.ws + OFF_MOD);
  u16* H1 = (u16*)(p.ws + OFF_H1);
  for (int tb = gw; tb < NT; tb += 2 * nw) {
    float4 v[2][4];
    float ss[2];
#pragma unroll
    for (int u = 0; u < 2; u++) {
      const int t = min(tb + u * nw, NT - 1);
      const float4* x = (const float4*)xrow(p, t);
#pragma unroll
      for (int i = 0; i < 4; i++) v[u][i] = x[lane + i * 64];
    }
#pragma unroll
    for (int u = 0; u < 2; u++) {
      ss[u] = 0.f;
#pragma unroll
      for (int i = 0; i < 4; i++) ss[u] += sq4(v[u][i]);
      ss[u] = wave_sum(ss[u]);
    }
#pragma unroll
    for (int u = 0; u < 2; u++) {
      const int t = tb + u * nw;
      if (t < NT) {
        const float* mod = MOD + cvof(t) * 6144;
        const float rstd = rsqrtf(ss[u] * (1.f / 1024.f) + EPS);
        uint32_t hp[4][2];
#pragma unroll
        for (int i = 0; i < 4; i++) {
          const int col = (lane + i * 64) * 4;
          const float4 g = *(const float4*)(p.g_pre_mix + col);
          const float4 sh = *(const float4*)(mod + col);
          const float4 sc = *(const float4*)(mod + 1024 + col);
          float h0 = v[u][i].x * rstd * g.x * (1.f + sc.x) + sh.x;
          float h1 = v[u][i].y * rstd * g.y * (1.f + sc.y) + sh.y;
          float h2 = v[u][i].z * rstd * g.z * (1.f + sc.z) + sh.z;
          float h3 = v[u][i].w * rstd * g.w * (1.f + sc.w) + sh.w;
          hp[i][0] = pack2(h0, h1);
          hp[i][1] = pack2(h2, h3);
        }
        store_pair16(H1 + (size_t)t * D, lane, 0, hp[0][0], hp[0][1], hp[1][0], hp[1][1]);
        store_pair16(H1 + (size_t)t * D, lane, 2, hp[2][0], hp[2][1], hp[3][0], hp[3][1]);
      }
    }
  }
}

__device__ void phase_gemm_in(const Params& p, char* smem) {
  const u16* H1 = (const u16*)(p.ws + OFF_H1);
  const u16* WT = (const u16*)(p.ws + OFF_WT_IN);
  u16* Pqkv = (u16*)(p.ws + OFF_PQKV);
  u16* Pz = (u16*)(p.ws + OFF_PZ);
  u16* Ppool = (u16*)(p.ws + OFF_PPOOL);
  u16* Pgate = (u16*)p.out;
  float* AB = (float*)(p.ws + OFF_AB);
  TILE_COORDS
  for_tiles(80, 19, [&](int m, int n) {
    f32x4 acc[8][4];
    zero_acc(acc);
    gemm_tile_acc(H1 + (size_t)m * 256 * 1024, 1024, WT + (size_t)n * 256 * 1024, 1024, 1024, smem, acc);
    const int n0 = n * 256;
    u16* dst;
    int ld, cb;
    bool sig = false;
    if (n0 < 1536) { dst = Pqkv; ld = 1536; cb = n0; }
    else if (n0 < 2048) { dst = Pz; ld = 512; cb = n0 - 1536; }
    else if (n0 < 2560) { dst = Ppool; ld = 512; cb = n0 - 2048; }
    else if (n0 < 4608) { dst = Pgate; ld = 2048; cb = n0 - 2560; sig = true; }
    else { dst = nullptr; ld = 0; cb = 0; }
#pragma unroll
    for (int mi = 0; mi < 8; mi++) {
      const int row = m * 256 + wr * 128 + mi * 16 + fr;
      if (dst) {
        f32x4 a[4];
#pragma unroll
        for (int ni = 0; ni < 4; ni++) {
          a[ni] = acc[mi][ni];
          if (sig) { a[ni][0] = sigmoidf_(a[ni][0]); a[ni][1] = sigmoidf_(a[ni][1]); a[ni][2] = sigmoidf_(a[ni][2]); a[ni][3] = sigmoidf_(a[ni][3]); }
        }
        store16_bf16(dst + (size_t)row * ld + cb + wc * 64 + fq * 16, a);
      } else if (wc == 0 && fq == 0) {
#pragma unroll
        for (int ni = 0; ni < 4; ni++) {
          f32x4 v = acc[mi][ni];
          *(float4*)(AB + (size_t)row * 16 + ni * 4) = make_float4(v[0], v[1], v[2], v[3]);
        }
      }
    }
  });
}

__device__ __forceinline__ void add8(float* s, const uint4& u) {
  s[0] += lo2f(u.x); s[1] += hi2f(u.x); s[2] += lo2f(u.y); s[3] += hi2f(u.y);
  s[4] += lo2f(u.z); s[5] += hi2f(u.z); s[6] += lo2f(u.w); s[7] += hi2f(u.w);
}

template <int HW>
__device__ __forceinline__ void pool_lat_item(const u16* __restrict__ Ppool, u16* __restrict__ Dp, int b, int rb, int cv,
                                              int lane) {
  constexpr int NR = 8 + 2 * HW;
  const int base = NCTX + b * 2048;
  const int r0 = rb * 8;
  const int col = cv * 8;
  uint4 U[NR];
#pragma unroll
  for (int k = 0; k < NR; k++) {
    const int r = r0 - HW + k;
    const int rc = min(max(r, 0), 31);
    const uint4 v = *(const uint4*)(Ppool + (size_t)(base + rc * 64 + lane) * 512 + col);
    U[k] = (r == rc) ? v : make_uint4(0, 0, 0, 0);
  }
  const int clo = max(lane - HW, 0), chi = min(lane + HW, 64);
  const float cntc = (float)(chi - clo);
#pragma unroll
  for (int i = 0; i < 8; i++) {
    const int r = r0 + i;
    float V[8];
#pragma unroll
    for (int j = 0; j < 8; j++) V[j] = 0.f;
#pragma unroll
    for (int k = 0; k < 2 * HW; k++) add8(V, U[i + k]);
    float H[8];
#pragma unroll
    for (int j = 0; j < 8; j++) {
      float a = V[j];
      float b = __int_as_float(__builtin_amdgcn_update_dpp(0, __float_as_int(V[j]), 0x138, 0xF, 0xF, false));
      if (HW > 1) {
        a += __int_as_float(__builtin_amdgcn_update_dpp(0, __float_as_int(a), 0x130, 0xF, 0xF, false));
        b += __int_as_float(__builtin_amdgcn_update_dpp(0, __float_as_int(b), 0x138, 0xF, 0xF, false));
      }
#pragma unroll
      for (int k = 2; k < HW; k <<= 1) {
        float t = __shfl(a, (lane + k) & 63);
        a += (lane + k < 64) ? t : 0.f;
        t = __shfl(b, (lane - k) & 63);
        b += (lane - k >= 0) ? t : 0.f;
      }
      H[j] = a + b;
    }
    const float cntr = (float)(min(r + HW, 32) - max(r - HW, 0));
    const float inv = 1.f / (cntr * cntc);
    float fs[8];
    unpack8(U[i + HW], fs);
    uint4 o;
    o.x = pack2(H[0] * inv - fs[0], H[1] * inv - fs[1]);
    o.y = pack2(H[2] * inv - fs[2], H[3] * inv - fs[3]);
    o.z = pack2(H[4] * inv - fs[4], H[5] * inv - fs[5]);
    o.w = pack2(H[6] * inv - fs[6], H[7] * inv - fs[7]);
    *(uint4*)(Dp + (size_t)(base + r * 64 + lane) * 512 + col) = o;
  }
}

template <int HW>
__device__ __forceinline__ void pool_ctx_item(const u16* __restrict__ Ppool, u16* __restrict__ Dp, int sg, int cv, int lane) {
  const int t = sg * 64 + lane;
  const int s_lo = t & ~255, pos = t - s_lo;
  const int col = cv * 8;
  uint4 U[2 * HW];
#pragma unroll
  for (int k = 0; k < 2 * HW; k++) {
    const int tt = pos - HW + k;
    const int tcl = min(max(tt, 0), 255);
    const uint4 v = *(const uint4*)(Ppool + (size_t)(s_lo + tcl) * 512 + col);
    U[k] = (tt == tcl) ? v : make_uint4(0, 0, 0, 0);
  }
  float S[8];
#pragma unroll
  for (int j = 0; j < 8; j++) S[j] = 0.f;
#pragma unroll
  for (int k = 0; k < 2 * HW; k++) add8(S, U[k]);
  const float inv = 1.f / (float)(min(pos + HW, 256) - max(pos - HW, 0));
  float fs[8];
  unpack8(U[HW], fs);
  uint4 o;
  o.x = pack2(S[0] * inv - fs[0], S[1] * inv - fs[1]);
  o.y = pack2(S[2] * inv - fs[2], S[3] * inv - fs[3]);
  o.z = pack2(S[4] * inv - fs[4], S[5] * inv - fs[5]);
  o.w = pack2(S[6] * inv - fs[6], S[7] * inv - fs[7]);
  *(uint4*)(Dp + (size_t)t * 512 + col) = o;
}

__device__ void phase_conv_pool(const Params& p) {
  const int tidx = opaque_tid();
  const int lane0 = tidx & 63;
  const int nwb = blockDim.x >> 6;
  const int gw = blockIdx.x * nwb + (tidx >> 6), nw = gridDim.x * nwb;
  const u16* Pqkv = (const u16*)(p.ws + OFF_PQKV);
  const u16* Ppool = (const u16*)(p.ws + OFF_PPOOL);
  u16* QKV = (u16*)(p.ws + OFF_QKV);
  u16* Dp = (u16*)(p.ws + OFF_DP);
  for (int id = gw; id < 320 * 12; id += nw) {
    int lane = lane0;
    asm volatile("" : "+v"(lane));
    const int cg_ = id / 12, gq = id - cg_ * 12;
    int s_lo, s_hi;
    if (cg_ < 64) { s_lo = (cg_ >> 2) << 8; s_hi = s_lo + 256; }
    else { s_lo = NCTX + (((cg_ - 64) >> 5) << 11); s_hi = s_lo + 2048; }
    const int col = gq * 128 + lane * 2;
    float w0[5], w1[5];
#pragma unroll
    for (int j = 0; j < 5; j++) {
      float2 wv = *(const float2*)(p.conv_w + j * 1536 + col);
      w0[j] = wv.x; w1[j] = wv.y;
    }
    const int t0 = cg_ * 64;
    for (int sb = 0; sb < 2; sb++) {
      const int tb = t0 + sb * 32;
      uint32_t raw[36];
#pragma unroll
      for (int i = 0; i < 36; i++) {
        const int t = tb - 2 + i;
        const int tc = min(max(t, s_lo), s_hi - 1);
        const uint32_t v = *(const uint32_t*)(Pqkv + (size_t)tc * 1536 + col);
        raw[i] = (t == tc) ? v : 0u;
      }
#pragma unroll
      for (int i = 0; i < 32; i++) {
        float y0 = 0.f, y1 = 0.f;
#pragma unroll
        for (int j = 0; j < 5; j++) {
          y0 += w0[j] * lo2f(raw[i + j]);
          y1 += w1[j] * hi2f(raw[i + j]);
        }
        y0 = siluf_(y0); y1 = siluf_(y1);
        if (gq < 8) {
          float ss = wave_sum_dpp(y0 * y0 + y1 * y1);
          float sc = rsqrtf(ss + EPS);
          y0 *= sc; y1 *= sc;
        }
        *(uint32_t*)(QKV + (size_t)(tb + i) * 1536 + col) = pack2(y0, y1);
      }
    }
  }
  for (int id = gw; id < 2048; id += nw) {
    const int cv = id & 63, rb = (id >> 6) & 3, b = id >> 8;
    const int gi = cv >> 4;
    int lane = lane0;
    asm volatile("" : "+v"(lane));
    if (gi == 0) pool_lat_item<1>(Ppool, Dp, b, rb, cv, lane);
    else if (gi == 1) pool_lat_item<2>(Ppool, Dp, b, rb, cv, lane);
    else if (gi == 2) pool_lat_item<4>(Ppool, Dp, b, rb, cv, lane);
    else pool_lat_item<8>(Ppool, Dp, b, rb, cv, lane);
  }
  for (int id = gw; id < 4096; id += nw) {
    const int cv = id & 63, sg = id >> 6;
    const int gi = cv >> 4;
    int lane = lane0;
    asm volatile("" : "+v"(lane));
    if (gi == 0) pool_ctx_item<1>(Ppool, Dp, sg, cv, lane);
    else if (gi == 1) pool_ctx_item<2>(Ppool, Dp, sg, cv, lane);
    else if (gi == 2) pool_ctx_item<4>(Ppool, Dp, sg, cv, lane);
    else pool_ctx_item<8>(Ppool, Dp, sg, cv, lane);
  }
}

constexpr int PRE_LDS_BYTES = 70656;
__device__ void pre_item(const Params& p, int cg_, int h, char* smem_half) {
  u16* sq = (u16*)smem_half;
  u16* sk = sq + 64 * 136;
  float* sL = (float*)(sk + 64 * 136);
  float* ssc = sL + 2 * 64 * 68;
  const u16* QKV = (const u16*)(p.ws + OFF_QKV);
  const float* AB = (const float*)(p.ws + OFF_AB);
  u16* TINV = (u16*)(p.ws + OFF_TINV);
  u16* INTRA = (u16*)(p.ws + OFF_INTRA);
  float* EG = (float*)(p.ws + OFF_EG);
  float* BETA = (float*)(p.ws + OFF_BETA);
  float* EKD = (float*)(p.ws + OFF_EKD);
  int tid = threadIdx.x & 255;
  asm volatile("" : "+v"(tid));
  const int lane = tid & 63, w = tid >> 6, fr = lane & 15, fq = lane >> 4;
  const int t0 = cg_ * 64;
  const int item = cg_ * 4 + h;
  {
    uint4 lq[4], lk[4];
#pragma unroll
    for (int i = 0; i < 4; i++) {
      int c = tid + i * 256;
      int row = c >> 4, kc = (c & 15) * 8;
      const u16* src = QKV + (size_t)(t0 + row) * 1536 + h * 128 + kc;
      lq[i] = *(const uint4*)src;
      lk[i] = *(const uint4*)(src + 512);
    }
#pragma unroll
    for (int i = 0; i < 4; i++) {
      int c = tid + i * 256;
      int row = c >> 4, kc = (c & 15) * 8;
      *(uint4*)(sq + row * 136 + kc) = lq[i];
      *(uint4*)(sk + row * 136 + kc) = lk[i];
    }
  }
  if (tid < 128) {
    const int d = tid >> 6, i = tid & 63;
    const float a = AB[(size_t)(t0 + i) * 16 + d * 4 + h];
    const float b = AB[(size_t)(t0 + i) * 16 + 8 + d * 4 + h];
    const float xs = a + p.dt_bias[d * 4 + h];
    const float sp = xs > 20.f ? xs : log1pf(__expf(xs));
    const float g = -__expf(p.a_log[d * 4 + h]) * sp;
    const float beta = sigmoidf_(b);
    float v = g;
    if (d == 0) {
#pragma unroll
      for (int o = 1; o < 64; o <<= 1) { float u = __shfl_up(v, o); if (lane >= o) v += u; }
    } else {
#pragma unroll
      for (int o = 1; o < 64; o <<= 1) { float u = __shfl_down(v, o); if (lane + o < 64) v += u; }
    }
    const float gl = __shfl(v, d == 0 ? 63 : 0);
    ssc[d * 64 + i] = v;
    ssc[128 + d * 64 + i] = beta;
    const size_t so = (size_t)(item * 2 + d) * 64 + i;
    EG[so] = __expf(v);
    BETA[so] = __expf(gl);
    EKD[so] = __expf(gl - v);
  }
  __syncthreads();
  {
    bf16x8 ak[4], aq[4];
#pragma unroll
    for (int ks = 0; ks < 4; ks++) {
      ak[ks] = *(const bf16x8*)(sk + (16 * w + fr) * 136 + ks * 32 + fq * 8);
      aq[ks] = *(const bf16x8*)(sq + (16 * w + fr) * 136 + ks * 32 + fq * 8);
    }
    float* L0 = sL;
    float* L1 = sL + 64 * 68;
    u16* I0 = INTRA + (size_t)(item * 2 + 0) * 4096;
    u16* I1 = INTRA + (size_t)(item * 2 + 1) * 4096;
#pragma unroll
    for (int jt = 0; jt < 4; jt++) {
      f32x4 aK = {0.f, 0.f, 0.f, 0.f}, aQ = {0.f, 0.f, 0.f, 0.f};
#pragma unroll
      for (int ks = 0; ks < 4; ks++) {
        bf16x8 b = *(const bf16x8*)(sk + (16 * jt + fr) * 136 + ks * 32 + fq * 8);
        aK = __builtin_amdgcn_mfma_f32_16x16x32_bf16(ak[ks], b, aK, 0, 0, 0);
        aQ = __builtin_amdgcn_mfma_f32_16x16x32_bf16(aq[ks], b, aQ, 0, 0, 0);
      }
      const int j = 16 * jt + fr;
      const float gc0j = ssc[j], g1j = ssc[64 + j];
#pragma unroll
      for (int jj = 0; jj < 4; jj++) {
        const int i = 16 * w + fq * 4 + jj;
        const float kkv = aK[jj], qkv = aQ[jj] * QSCALE;
        const float e0 = __expf(fminf(ssc[i] - gc0j, 0.f));
        const float e1 = __expf(fminf(ssc[64 + i] - g1j, 0.f));
        const float l0v = ssc[128 + i] * kkv * e0, l1v = ssc[192 + i] * kkv * e1;
        L0[j * 68 + i] = (i > j) ? l0v : 0.f;
        L1[(63 - j) * 68 + (63 - i)] = (i < j) ? l1v : 0.f;
        I0[i * 64 + j] = f2bf((i >= j) ? qkv * e0 : 0.f);
        I1[i * 64 + j] = f2bf((i <= j) ? qkv * e1 : 0.f);
      }
    }
  }
  __syncthreads();
  if (w < 2) {
    float* Lp = sL + w * 64 * 68;
    const int c = lane;
    float x[64];
#pragma unroll
    for (int i = 0; i < 64; i++) x[i] = (i == c) ? 1.f : 0.f;
#pragma unroll
    for (int j = 0; j < 63; j++) {
      const float xj = x[j];
#pragma unroll
      for (int i4 = (j + 1) / 4; i4 < 16; i4++) {
        const float4 l = *(const float4*)(Lp + j * 68 + i4 * 4);
        if (i4 * 4 + 0 > j) x[i4 * 4 + 0] -= l.x * xj;
        if (i4 * 4 + 1 > j) x[i4 * 4 + 1] -= l.y * xj;
        if (i4 * 4 + 2 > j) x[i4 * 4 + 2] -= l.z * xj;
        if (i4 * 4 + 3 > j) x[i4 * 4 + 3] -= l.w * xj;
      }
      if (j & 1) asm volatile("" ::: "memory");
    }
    u16* sX = (u16*)Lp;
    const float bcol = (w == 0) ? ssc[128 + c] : ssc[192 + 63 - c];
    if (w == 0) {
#pragma unroll
      for (int r = 0; r < 64; r++) sX[r * 64 + c] = f2bf(x[r] * bcol);
    } else {
#pragma unroll
      for (int r = 0; r < 64; r++) sX[(63 - r) * 64 + (63 - c)] = f2bf(x[r] * bcol);
    }
  }
  __syncthreads();
  if (w < 2) {
    const u16* sX = (const u16*)(sL + w * 64 * 68);
    u16* T = TINV + (size_t)(item * 2 + w) * 4096;
#pragma unroll
    for (int i = 0; i < 8; i++) *(uint4*)(T + (i * 64 + lane) * 8) = *(const uint4*)(sX + (i * 64 + lane) * 8);
  }
  __syncthreads();
}

__device__ void phase_pre(const Params& p, char* smem) {
  const int half = opaque_tid() >> 8;
  for (int pr = blockIdx.x; pr < 640; pr += gridDim.x) {
    const int it = pr * 2 + half;
    pre_item(p, it >> 2, it & 3, smem + half * PRE_LDS_BYTES);
  }
}

__device__ __forceinline__ void pool_linear(const Params& p, char* smem, int bid, int G) {
  const u16* Dp = (const u16*)(p.ws + OFF_DP);
  const u16* WTP = (const u16*)(p.ws + OFF_WT_POOL);
  u16* YB = (u16*)(p.ws + OFF_YB);
  TILE_COORDS
  for_tiles(128, 2, [&](int m, int n) {
    f32x4 acc[5][4];
    zero_acc(acc);
    gemm_tile_acc(Dp + (size_t)m * 160 * 512, 512, WTP + (size_t)n * 256 * 512, 512, 512, smem, acc);
#pragma unroll
    for (int mi = 0; mi < 5; mi++) {
      const int row = m * 160 + wr * 80 + mi * 16 + fr;
      const int colb = n * 256 + wc * 64 + fq * 16;
      f32x4 a[4];
#pragma unroll
      for (int ni = 0; ni < 4; ni++) {
        const float4 sc = *(const float4*)(p.pool_scale + colb + ni * 4);
        a[ni] = acc[mi][ni];
        a[ni][0] *= sc.x; a[ni][1] *= sc.y; a[ni][2] *= sc.z; a[ni][3] *= sc.w;
      }
      store16_bf16(YB + (size_t)row * 512 + colb, a);
    }
  }, bid, G);
}

constexpr int SCAN_LDS_U16 = 32 * 136 + 3 * 64 * 72;
constexpr int SCAN_SHARED_U16 = 2 * 64 * 136 + 2 * 64 * 72;
__device__ void scan_chain(const Params& p, int chain, int vq, char* smem_c) {
  const int tidx = opaque_tid();
  const int vh = tidx >> 8;
  const int tid = tidx & 255, lane = tid & 63, w = tid >> 6, fr = lane & 15, fq = lane >> 4;
  const bool lat = chain < 64;
  const int cc = lat ? chain : chain - 64;
  const int sb = cc >> 3, h = (cc >> 1) & 3, d = cc & 1;
  const int cg0 = lat ? 64 + sb * 32 : sb * 4;
  const int nch = lat ? 32 : 4;
  u16* sk = (u16*)smem_c;
  u16* sq = sk + 64 * 136;
  u16* sT = sq + 64 * 136;
  u16* sI = sT + 64 * 72;
  u16* ST = sI + 64 * 72 + vh * SCAN_LDS_U16;
  u16* RT = ST + 32 * 136;
  u16* VNT = RT + 64 * 72;
  u16* VNST = VNT + 64 * 72;
  const u16* QKV = (const u16*)(p.ws + OFF_QKV);
  const u16* TINV = (const u16*)(p.ws + OFF_TINV);
  const u16* INTRA = (const u16*)(p.ws + OFF_INTRA);
  const float* EG = (const float*)(p.ws + OFF_EG);
  const float* EKD = (const float*)(p.ws + OFF_EKD);
  const float* EGLB = (const float*)(p.ws + OFF_BETA);
  u16* OD = (u16*)(p.ws + (d ? OFF_OB : OFF_OF));
  const int voff = vq * 64 + vh * 32;
  const int vbase = h * 128 + voff;

  f32x4 S[2][2];
  if (lat) {
    const float* s0 = p.state_delta + (size_t)((sb * 2 + d) * 4 + h) * 16384;
#pragma unroll
    for (int kt = 0; kt < 2; kt++)
#pragma unroll
      for (int vt = 0; vt < 2; vt++)
#pragma unroll
        for (int jj = 0; jj < 4; jj++)
          S[kt][vt][jj] = s0[(32 * w + kt * 16 + fq * 4 + jj) * 128 + voff + vt * 16 + fr];
  } else {
#pragma unroll
    for (int kt = 0; kt < 2; kt++)
#pragma unroll
      for (int vt = 0; vt < 2; vt++) S[kt][vt] = f32x4{0.f, 0.f, 0.f, 0.f};
  }

  auto chunk_of = [&](int step) { const int st = min(step, nch - 1); return cg0 + (d ? nch - 1 - st : st); };
  u32x4 stg[6];
  auto load_stage = [&](int step) {
    const int cg_ = chunk_of(step);
    const int itd = (cg_ * 4 + h) * 2 + d;
#pragma unroll
    for (int i = 0; i < 2; i++) {
      const int c = tidx + i * 512, row = c >> 4, kc = (c & 15) * 8;
      const u16* src = QKV + (size_t)(cg_ * 64 + row) * 1536 + h * 128 + kc;
      stg[i] = *(const u32x4*)(src + 512);
      stg[2 + i] = *(const u32x4*)src;
    }
    const int row = tidx >> 3, c8 = (tidx & 7) * 8;
    stg[4] = *(const u32x4*)(TINV + (size_t)itd * 4096 + row * 64 + c8);
    stg[5] = *(const u32x4*)(INTRA + (size_t)itd * 4096 + row * 64 + c8);
  };
  auto write_stage = [&]() {
#pragma unroll
    for (int i = 0; i < 2; i++) {
      const int c = tidx + i * 512, row = c >> 4, kc = (c & 15) * 8;
      *(u32x4*)(sk + row * 136 + kc) = stg[i];
      *(u32x4*)(sq + row * 136 + kc) = stg[2 + i];
    }
    const int row = tidx >> 3, c8 = (tidx & 7) * 8;
    *(u32x4*)(sT + row * 72 + c8) = stg[4];
    *(u32x4*)(sI + row * 72 + c8) = stg[5];
  };
  u16 vv[2][4];
  float4 eg, ek;
  float egl;
  auto load_small = [&](int step) {
    const int cg_ = chunk_of(step);
    const int t0 = cg_ * 64;
    const int itd = (cg_ * 4 + h) * 2 + d;
#pragma unroll
    for (int vt = 0; vt < 2; vt++)
#pragma unroll
      for (int jj = 0; jj < 4; jj++)
        vv[vt][jj] = QKV[(size_t)(t0 + 16 * w + fq * 4 + jj) * 1536 + 1024 + vbase + vt * 16 + fr];
    eg = *(const float4*)(EG + (size_t)itd * 64 + 16 * w + fq * 4);
    ek = *(const float4*)(EKD + (size_t)itd * 64 + 16 * w + fq * 4);
    egl = EGLB[(size_t)itd * 64 + lane];
  };
#define RAW_BARRIER()                                        \
  do {                                                       \
    __builtin_amdgcn_sched_barrier(0);                       \
    asm volatile("s_waitcnt lgkmcnt(0)" ::: "memory");       \
    __builtin_amdgcn_s_barrier();                            \
    asm volatile("" ::: "memory");                           \
    __builtin_amdgcn_sched_barrier(0);                       \
  } while (0)
  load_stage(0);
  load_small(0);
  __syncthreads();

  for (int step = 0; step < nch; step++) {
    const int t0 = chunk_of(step) * 64;
    write_stage();
#pragma unroll
    for (int kt = 0; kt < 2; kt++)
#pragma unroll
      for (int vt = 0; vt < 2; vt++)
        *(uint2*)(ST + (vt * 16 + fr) * 136 + 32 * w + kt * 16 + fq * 4) =
            make_uint2(pack2(S[kt][vt][0], S[kt][vt][1]), pack2(S[kt][vt][2], S[kt][vt][3]));
    load_stage(step + 1);
    RAW_BARRIER();
    f32x4 oq[2];
    {
      bf16x8 ak[4], aq[4];
#pragma unroll
      for (int ks = 0; ks < 4; ks++) {
        ak[ks] = *(const bf16x8*)(sk + (16 * w + fr) * 136 + ks * 32 + fq * 8);
        aq[ks] = *(const bf16x8*)(sq + (16 * w + fr) * 136 + ks * 32 + fq * 8);
      }
      const float egv[4] = {eg.x, eg.y, eg.z, eg.w};
#pragma unroll
      for (int vt = 0; vt < 2; vt++) {
        f32x4 ksa = {0.f, 0.f, 0.f, 0.f}, qsa = {0.f, 0.f, 0.f, 0.f};
#pragma unroll
        for (int ks = 0; ks < 4; ks++) {
          bf16x8 b = *(const bf16x8*)(ST + (vt * 16 + fr) * 136 + ks * 32 + fq * 8);
          ksa = __builtin_amdgcn_mfma_f32_16x16x32_bf16(ak[ks], b, ksa, 0, 0, 0);
          qsa = __builtin_amdgcn_mfma_f32_16x16x32_bf16(aq[ks], b, qsa, 0, 0, 0);
        }
        float r[4];
#pragma unroll
        for (int jj = 0; jj < 4; jj++) {
          r[jj] = bf2f(vv[vt][jj]) - egv[jj] * ksa[jj];
          oq[vt][jj] = egv[jj] * QSCALE * qsa[jj];
        }
        *(uint2*)(RT + (vt * 16 + fr) * 72 + 16 * w + fq * 4) = make_uint2(pack2(r[0], r[1]), pack2(r[2], r[3]));
      }
    }
    const float4 ek_c = ek;
    const float egl_c = egl;
    load_small(step + 1);
    RAW_BARRIER();
    {
      bf16x8 aT[2];
#pragma unroll
      for (int js = 0; js < 2; js++) aT[js] = *(const bf16x8*)(sT + (16 * w + fr) * 72 + js * 32 + fq * 8);
      const float ekv[4] = {ek_c.x, ek_c.y, ek_c.z, ek_c.w};
#pragma unroll
      for (int vt = 0; vt < 2; vt++) {
        f32x4 vn = {0.f, 0.f, 0.f, 0.f};
#pragma unroll
        for (int js = 0; js < 2; js++) {
          bf16x8 b = *(const bf16x8*)(RT + (vt * 16 + fr) * 72 + js * 32 + fq * 8);
          vn = __builtin_amdgcn_mfma_f32_16x16x32_bf16(aT[js], b, vn, 0, 0, 0);
        }
        *(uint2*)(VNT + (vt * 16 + fr) * 72 + 16 * w + fq * 4) = make_uint2(pack2(vn[0], vn[1]), pack2(vn[2], vn[3]));
        *(uint2*)(VNST + (vt * 16 + fr) * 72 + 16 * w + fq * 4) =
            make_uint2(pack2(vn[0] * ekv[0], vn[1] * ekv[1]), pack2(vn[2] * ekv[2], vn[3] * ekv[3]));
      }
    }
    RAW_BARRIER();
    {
      bf16x8 aI[2], aK[2][2];
#pragma unroll
      for (int js = 0; js < 2; js++) {
        aI[js] = *(const bf16x8*)(sI + (16 * w + fr) * 72 + js * 32 + fq * 8);
#pragma unroll
        for (int kt = 0; kt < 2; kt++) {
          const u16* kp = sk + (js * 32 + fq * 8) * 136 + 32 * w + kt * 16 + fr;
          bf16x8 f;
#pragma unroll
          for (int j = 0; j < 8; j++) f[j] = (short)kp[j * 136];
          aK[kt][js] = f;
        }
      }
#pragma unroll
      for (int vt = 0; vt < 2; vt++) {
        bf16x8 bv[2], bs[2];
#pragma unroll
        for (int js = 0; js < 2; js++) {
          bv[js] = *(const bf16x8*)(VNT + (vt * 16 + fr) * 72 + js * 32 + fq * 8);
          bs[js] = *(const bf16x8*)(VNST + (vt * 16 + fr) * 72 + js * 32 + fq * 8);
        }
#pragma unroll
        for (int js = 0; js < 2; js++) oq[vt] = __builtin_amdgcn_mfma_f32_16x16x32_bf16(aI[js], bv[js], oq[vt], 0, 0, 0);
#pragma unroll
        for (int kt = 0; kt < 2; kt++) {
          f32x4 sv = S[kt][vt];
          sv[0] *= egl_c; sv[1] *= egl_c; sv[2] *= egl_c; sv[3] *= egl_c;
#pragma unroll
          for (int js = 0; js < 2; js++) sv = __builtin_amdgcn_mfma_f32_16x16x32_bf16(aK[kt][js], bs[js], sv, 0, 0, 0);
          S[kt][vt] = sv;
        }
      }
    }
#pragma unroll
    for (int vt = 0; vt < 2; vt++)
#pragma unroll
      for (int jj = 0; jj < 4; jj++) RT[(16 * w + fq * 4 + jj) * 72 + vt * 16 + fr] = f2bf(oq[vt][jj]);
    RAW_BARRIER();
    {
      const int row = tid >> 2, cc8 = (tid & 3) * 8;
      *(uint4*)(OD + (size_t)(t0 + row) * 512 + vbase + cc8) = *(const uint4*)(RT + row * 72 + cc8);
    }
  }
#undef RAW_BARRIER
  if (!lat) {
    float* so = p.out + (size_t)NT * D + (size_t)((sb * 2 + d) * 4 + h) * 16384;
#pragma unroll
    for (int kt = 0; kt < 2; kt++)
#pragma unroll
      for (int vt = 0; vt < 2; vt++)
#pragma unroll
        for (int jj = 0; jj < 4; jj++)
          so[(32 * w + kt * 16 + fq * 4 + jj) * 128 + voff + vt * 16 + fr] = S[kt][vt][jj];
  }
  __syncthreads();
}

__device__ void phase_scan(const Params& p, char* smem) {
  static_assert((SCAN_SHARED_U16 + 2 * SCAN_LDS_U16) * 2 <= SMEM_BYTES - 16, "scan LDS");
  for (int it = blockIdx.x; it < 384; it += gridDim.x) {
    int chain, vq;
    if (it < 128) { chain = it & 63; vq = it >> 6; }
    else { chain = 64 + ((it - 128) >> 1); vq = (it - 128) & 1; }
    scan_chain(p, chain, vq, smem);
  }
  if (gridDim.x > 128) {
    if (blockIdx.x >= 128) {
      pool_linear(p, smem, blockIdx.x - 128, gridDim.x - 128);
      deferred_weight_prep(p, smem, blockIdx.x - 128, gridDim.x - 128);
    }
  } else {
    pool_linear(p, smem, blockIdx.x, gridDim.x);
    deferred_weight_prep(p, smem, blockIdx.x, gridDim.x);
  }
}

__device__ void phase_ya(const Params& p) {
  const int tidx = opaque_tid();
  const int lane = tidx & 63;
  const int nwb = blockDim.x >> 6;
  const int gw = blockIdx.x * nwb + (tidx >> 6), nw = gridDim.x * nwb;
  const u16* OF = (const u16*)(p.ws + OFF_OF);
  const u16* OB = (const u16*)(p.ws + OFF_OB);
  const u16* Pz = (const u16*)(p.ws + OFF_PZ);
  u16* YA = (u16*)(p.ws + OFF_YA);
  const int cl = lane & 15;
  float gn[8];
#pragma unroll
  for (int j = 0; j < 8; j++) gn[j] = p.g_onorm[cl * 8 + j];
  for (int tb = gw; tb < NT; tb += 2 * nw) {
    uint4 ua[2], ub[2], uz[2];
#pragma unroll
    for (int u = 0; u < 2; u++) {
      const int t = min(tb + u * nw, NT - 1);
      const size_t off = (size_t)t * 512 + lane * 8;
      ua[u] = *(const uint4*)(OF + off);
      ub[u] = *(const uint4*)(OB + off);
      uz[u] = *(const uint4*)(Pz + off);
    }
#pragma unroll
    for (int u = 0; u < 2; u++) {
      const int t = tb + u * nw;
      float a[8], b[8], z[8];
      unpack8(ua[u], a);
      unpack8(ub[u], b);
      unpack8(uz[u], z);
      float ss = 0.f;
#pragma unroll
      for (int j = 0; j < 8; j++) { a[j] += b[j]; ss += a[j] * a[j]; }
      ss += __shfl_xor(ss, 8); ss += __shfl_xor(ss, 4); ss += __shfl_xor(ss, 2); ss += __shfl_xor(ss, 1);
      const float rstd = rsqrtf(ss * (1.f / 128.f) + EPS);
      float y[8];
#pragma unroll
      for (int j = 0; j < 8; j++) y[j] = a[j] * rstd * gn[j] * siluf_(z[j]);
      if (t < NT)
        *(uint4*)(YA + (size_t)t * 512 + lane * 8) =
            make_uint4(pack2(y[0], y[1]), pack2(y[2], y[3]), pack2(y[4], y[5]), pack2(y[6], y[7]));
    }
  }
}

__device__ void phase_merge(const Params& p, char* smem) {
  const u16* YA = (const u16*)(p.ws + OFF_YA);
  const u16* YB = (const u16*)(p.ws + OFF_YB);
  const u16* WA = (const u16*)(p.ws + OFF_WT_A);
  const u16* WB = (const u16*)(p.ws + OFF_WT_B);
  const u16* Pgate = (const u16*)p.out;
  u16* MG = (u16*)(p.ws + OFF_MG);
  TILE_COORDS
  for_tiles(128, 4, [&](int m, int n) {
    f32x4 acc[5][4];
    zero_acc(acc);
    gemm_tile_acc(YA + (size_t)m * 160 * 512, 512, WA + (size_t)n * 256 * 512, 512, 512, smem, acc);
#pragma unroll
    for (int mi = 0; mi < 5; mi++) {
      const int row = m * 160 + wr * 80 + mi * 16 + fr;
      const int colb = n * 256 + wc * 64 + fq * 16;
      float g[16];
      load16_bf16(Pgate + (size_t)row * 2048 + colb, g);
      f32x4 a[4];
#pragma unroll
      for (int ni = 0; ni < 4; ni++) {
        a[ni] = acc[mi][ni];
        a[ni][0] *= g[ni * 4 + 0]; a[ni][1] *= g[ni * 4 + 1]; a[ni][2] *= g[ni * 4 + 2]; a[ni][3] *= g[ni * 4 + 3];
      }
      store16_bf16(MG + (size_t)row * 1024 + colb, a);
    }
  });
  for_tiles(128, 4, [&](int m, int n) {
    f32x4 acc[5][4];
    zero_acc(acc);
    gemm_tile_acc(YB + (size_t)m * 160 * 512, 512, WB + (size_t)n * 256 * 512, 512, 512, smem, acc);
#pragma unroll
    for (int mi = 0; mi < 5; mi++) {
      const int row = m * 160 + wr * 80 + mi * 16 + fr;
      const int colb = n * 256 + wc * 64 + fq * 16;
      float g[16], mm[16];
      load16_bf16(Pgate + (size_t)row * 2048 + 1024 + colb, g);
      load16_bf16(MG + (size_t)row * 1024 + colb, mm);
      f32x4 a[4];
#pragma unroll
      for (int ni = 0; ni < 4; ni++) {
        a[ni] = acc[mi][ni];
        a[ni][0] = mm[ni * 4 + 0] + a[ni][0] * g[ni * 4 + 0]; a[ni][1] = mm[ni * 4 + 1] + a[ni][1] * g[ni * 4 + 1];
        a[ni][2] = mm[ni * 4 + 2] + a[ni][2] * g[ni * 4 + 2]; a[ni][3] = mm[ni * 4 + 3] + a[ni][3] * g[ni * 4 + 3];
      }
      store16_bf16(MG + (size_t)row * 1024 + colb, a);
    }
  });
}

template <int lda, int K>
__device__ void phase_gemm_f32(const u16* A, const u16* Bt, u16* C, char* smem) {
  TILE_COORDS
  for_tiles(128, 4, [&](int m, int n) {
    f32x4 acc[5][4];
    zero_acc(acc);
    gemm_tile_acc(A + (size_t)m * 160 * lda, lda, Bt + (size_t)n * 256 * K, K, K, smem, acc);
#pragma unroll
    for (int mi = 0; mi < 5; mi++) {
      const int row = m * 160 + wr * 80 + mi * 16 + fr;
      store16_bf16(C + (size_t)row * 1024 + n * 256 + wc * 64 + fq * 16, acc[mi]);
    }
  });
}

__device__ __forceinline__ float4 bf4(const uint2& u) { return make_float4(lo2f(u.x), hi2f(u.x), lo2f(u.y), hi2f(u.y)); }
__device__ void phase_mid(const Params& p) {
  const int tidx = opaque_tid();
  const int lane = tidx & 63;
  const int nwb = blockDim.x >> 6;
  const int gw = blockIdx.x * nwb + (tidx >> 6), nw = gridDim.x * nwb;
  const float* MOD = (const float*)(p.ws + OFF_MOD);
  const u16* T1 = (const u16*)(p.ws + OFF_T1);
  u16* X1 = (u16*)(p.ws + OFF_X1);
  u16* H2 = (u16*)(p.ws + OFF_H2);
  for (int tb = gw; tb < NT; tb += 2 * nw) {
    uint2 tv[2][4];
    float4 xv[2][4];
#pragma unroll
    for (int u = 0; u < 2; u++) {
      const int t = min(tb + u * nw, NT - 1);
      const float4* x = (const float4*)xrow(p, t);
      const uint2* tr = (const uint2*)(T1 + (size_t)t * D);
#pragma unroll
      for (int i = 0; i < 4; i++) {
        tv[u][i] = tr[lane + i * 64];
        xv[u][i] = x[lane + i * 64];
      }
    }
#pragma unroll
    for (int u = 0; u < 2; u++) {
      const int t = tb + u * nw;
      if (t >= NT) continue;
      const float* mod = MOD + cvof(t) * 6144;
      float4 v[4];
      float ss = 0.f;
#pragma unroll
      for (int i = 0; i < 4; i++) { v[i] = bf4(tv[u][i]); ss += sq4(v[i]); }
      ss = wave_sum(ss);
      const float rs1 = rsqrtf(ss * (1.f / 1024.f) + EPS);
      float s2 = 0.f;
      uint32_t xp[4][2];
#pragma unroll
      for (int i = 0; i < 4; i++) {
        const int col = (lane + i * 64) * 4;
        const float4 g = *(const float4*)(p.g_post_mix + col);
        const float4 gt = *(const float4*)(mod + 2048 + col);
        xv[u][i].x += gt.x * (v[i].x * rs1 * g.x);
        xv[u][i].y += gt.y * (v[i].y * rs1 * g.y);
        xv[u][i].z += gt.z * (v[i].z * rs1 * g.z);
        xv[u][i].w += gt.w * (v[i].w * rs1 * g.w);
        s2 += sq4(xv[u][i]);
        xp[i][0] = pack2(xv[u][i].x, xv[u][i].y);
        xp[i][1] = pack2(xv[u][i].z, xv[u][i].w);
      }
      store_pair16(X1 + (size_t)t * D, lane, 0, xp[0][0], xp[0][1], xp[1][0], xp[1][1]);
      store_pair16(X1 + (size_t)t * D, lane, 2, xp[2][0], xp[2][1], xp[3][0], xp[3][1]);
      s2 = wave_sum(s2);
      const float rs2 = rsqrtf(s2 * (1.f / 1024.f) + EPS);
#pragma unroll
      for (int i = 0; i < 4; i++) {
        const int col = (lane + i * 64) * 4;
        const float4 g = *(const float4*)(p.g_pre_ffn + col);
        const float4 sh = *(const float4*)(mod + 3072 + col);
        const float4 sc = *(const float4*)(mod + 4096 + col);
        float h0 = xv[u][i].x * rs2 * g.x * (1.f + sc.x) + sh.x;
        float h1 = xv[u][i].y * rs2 * g.y * (1.f + sc.y) + sh.y;
        float h2 = xv[u][i].z * rs2 * g.z * (1.f + sc.z) + sh.z;
        float h3 = xv[u][i].w * rs2 * g.w * (1.f + sc.w) + sh.w;
        xp[i][0] = pack2(h0, h1);
        xp[i][1] = pack2(h2, h3);
      }
      store_pair16(H2 + (size_t)t * D, lane, 0, xp[0][0], xp[0][1], xp[1][0], xp[1][1]);
      store_pair16(H2 + (size_t)t * D, lane, 2, xp[2][0], xp[2][1], xp[3][0], xp[3][1]);
    }
  }
}

__device__ void phase_up(const Params& p, char* smem) {
  const u16* H2 = (const u16*)(p.ws + OFF_H2);
  const u16* WT = (const u16*)(p.ws + OFF_WT_UP);
  u16* ACT = (u16*)(p.ws + OFF_ACT);
  TILE_COORDS
  for_tiles(80, 22, [&](int m, int n) {
    f32x4 acc[8][4];
    zero_acc(acc);
    gemm_tile_acc(H2 + (size_t)m * 256 * 1024, 1024, WT + (size_t)n * 256 * 1024, 1024, 1024, smem, acc);
    const int jb = n * 128 + wc * 32;
#pragma unroll
    for (int mi = 0; mi < 8; mi++) {
      const int row = m * 256 + wr * 128 + mi * 16 + fr;
      const f32x4 g0 = acc[mi][0], g1 = acc[mi][1], u0 = acc[mi][2], u1 = acc[mi][3];
      *(uint4*)(ACT + (size_t)row * DFF + jb + fq * 8) =
          make_uint4(pack2(siluf_(g0[0]) * u0[0], siluf_(g0[1]) * u0[1]), pack2(siluf_(g0[2]) * u0[2], siluf_(g0[3]) * u0[3]),
                     pack2(siluf_(g1[0]) * u1[0], siluf_(g1[1]) * u1[1]), pack2(siluf_(g1[2]) * u1[2], siluf_(g1[3]) * u1[3]));
    }
  });
}

__device__ void phase_final(const Params& p) {
  const int tidx = opaque_tid();
  const int lane = tidx & 63;
  const int nwb = blockDim.x >> 6;
  const int gw = blockIdx.x * nwb + (tidx >> 6), nw = gridDim.x * nwb;
  const float* MOD = (const float*)(p.ws + OFF_MOD);
  const u16* T2 = (const u16*)(p.ws + OFF_T2);
  const u16* X1 = (const u16*)(p.ws + OFF_X1);
  for (int tb = gw; tb < NT; tb += 4 * nw) {
    uint2 tv[4][4], xr[4][4];
#pragma unroll
    for (int u = 0; u < 4; u++) {
      const int t = min(tb + u * nw, NT - 1);
      const uint2* tr = (const uint2*)(T2 + (size_t)t * D);
      const uint2* xp = (const uint2*)(X1 + (size_t)t * D);
#pragma unroll
      for (int i = 0; i < 4; i++) {
        tv[u][i] = tr[lane + i * 64];
        xr[u][i] = xp[lane + i * 64];
      }
    }
#pragma unroll
    for (int u = 0; u < 4; u++) {
      const int t = tb + u * nw;
      if (t >= NT) continue;
      const float* mod = MOD + cvof(t) * 6144;
      float4 v[4];
      float ss = 0.f;
#pragma unroll
      for (int i = 0; i < 4; i++) { v[i] = bf4(tv[u][i]); ss += sq4(v[i]); }
      ss = wave_sum(ss);
      const float rs = rsqrtf(ss * (1.f / 1024.f) + EPS);
#pragma unroll
      for (int i = 0; i < 4; i++) {
        const int col = (lane + i * 64) * 4;
        const float4 g = *(const float4*)(p.g_post_ffn + col);
        const float4 gt = *(const float4*)(mod + 5120 + col);
        float4 r = bf4(xr[u][i]);
        r.x += gt.x * (v[i].x * rs * g.x);
        r.y += gt.y * (v[i].y * rs * g.y);
        r.z += gt.z * (v[i].z * rs * g.z);
        r.w += gt.w * (v[i].w * rs * g.w);
        *(float4*)(p.out + (size_t)t * D + col) = r;
      }
    }
  }
}

#define XB_TMO      128
#define XB_XCNT(j)  (256  + 64 * (j))
#define XB_XSUB(j)  (1280 + 64 * (j))
#define XB_XGEN(j)  (2304 + 64 * (j))
#define XB_TOP      3328
#define XB_TOPGEN   3392
#define XCD_BAR_WORDS 3456
#define XB_SPIN_CAP (1u << 18)
#define LAS __attribute__((address_space(3)))
__device__ __forceinline__ unsigned xb_ld(unsigned* p) { return __hip_atomic_load(p, __ATOMIC_RELAXED, __HIP_MEMORY_SCOPE_AGENT); }
__device__ __forceinline__ unsigned xb_add(unsigned* p, unsigned v) { return __hip_atomic_fetch_add(p, v, __ATOMIC_RELAXED, __HIP_MEMORY_SCOPE_AGENT); }
__device__ __forceinline__ unsigned xb_xcc_id() { return (unsigned)__builtin_amdgcn_s_getreg((3 << 11) | 20) & 0xFu; }
#define XB_SPIN(cond, bar) do { unsigned _sp = 0; while (cond) { __builtin_amdgcn_s_sleep(1); \
    if ((++_sp & 255u) == 0u) { if (xb_ld(&(bar)[XB_TMO])) break; if (_sp > XB_SPIN_CAP) { atomicAdd(&(bar)[XB_TMO], 1u); break; } } } } while (0)
struct XcdBarrier {
  unsigned* bar; unsigned x;
  volatile LAS unsigned* st;
};
__device__ __forceinline__ XcdBarrier xcd_barrier_post(unsigned* bar, volatile LAS unsigned* st) {
  XcdBarrier b; b.bar = bar; b.x = xb_xcc_id(); b.st = st;
  if (threadIdx.x == 0) (void)xb_add(&bar[XB_XCNT(b.x)], 1u);
  return b;
}
__device__ __forceinline__ void xcd_barrier_complete(unsigned* bar, unsigned x, unsigned& nloc, unsigned& nx) {
  const unsigned G = gridDim.x * gridDim.y * gridDim.z;
  unsigned sum, cnt, mine, sp = 0u;
  for (;;) {
    sum = 0u; cnt = 0u; mine = 0u;
#pragma unroll
    for (unsigned j = 0; j < 16; ++j) { const unsigned c = xb_ld(&bar[XB_XCNT(j)]); sum += c; cnt += (c > 0u) ? 1u : 0u; mine = (j == x) ? c : mine; }
    if (sum == G) break;
    __builtin_amdgcn_s_sleep(1);
    if ((++sp & 255u) == 0u) { if (xb_ld(&bar[XB_TMO])) break; if (sp > XB_SPIN_CAP) { atomicAdd(&bar[XB_TMO], 1u); break; } }
  }
  nloc = mine > 0u ? mine : 1u; nx = cnt > 0u ? cnt : 1u;
}
__device__ __forceinline__ void xcd_barrier(unsigned* bar_, char* smem_) {
  asm volatile("s_waitcnt vmcnt(0)" ::: "memory");
  __syncthreads();
  if (threadIdx.x == 0) {
    XcdBarrier b; b.bar = bar_; b.x = xb_xcc_id(); b.st = (volatile LAS unsigned*)(smem_ + SMEM_BYTES - 16);
    unsigned* bar = b.bar;
    __builtin_amdgcn_s_waitcnt(0);
    unsigned nloc = b.st[0], nx = b.st[1];
    if (nloc == 0u) { xcd_barrier_complete(bar, b.x, nloc, nx); b.st[0] = nloc; b.st[1] = nx; }
    const unsigned old = xb_add(&bar[XB_XSUB(b.x)], 1u);
    const unsigned gen = old / nloc;
    if (old + 1u == (gen + 1u) * nloc) {
      __builtin_amdgcn_fence(__ATOMIC_RELEASE, "agent");
      asm volatile("s_waitcnt vmcnt(0)" ::: "memory");
      const unsigned og = xb_add(&bar[XB_TOP], 1u);
      const unsigned tg = og / nx;
      if (og + 1u == (tg + 1u) * nx) xb_add(&bar[XB_TOPGEN], 1u);
      else XB_SPIN(xb_ld(&bar[XB_TOPGEN]) == tg, bar);
      __builtin_amdgcn_fence(__ATOMIC_ACQUIRE, "agent");
      xb_add(&bar[XB_XGEN(b.x)], 1u);
      asm volatile("s_waitcnt vmcnt(0)" ::: "memory");
    } else {
      XB_SPIN(xb_ld(&bar[XB_XGEN(b.x)]) == gen, bar);
      __builtin_amdgcn_fence(__ATOMIC_ACQUIRE, "agent");
      asm volatile("s_waitcnt vmcnt(0)" ::: "memory");
    }
  }
  __syncthreads();
}

template <int PH>
__device__ __forceinline__ void run_phase(const Params& p, char* smem) {
  if (PH == 0) phase_prep(p, smem);
  else if (PH == 1) phase_h1(p);
  else if (PH == 2) phase_gemm_in(p, smem);
  else if (PH == 3) phase_conv_pool(p);
  else if (PH == 4) phase_pre(p, smem);
  else if (PH == 5) phase_scan(p, smem);
  else if (PH == 6) phase_ya(p);
  else if (PH == 7) phase_merge(p, smem);
  else if (PH == 8) phase_gemm_f32<1024, 1024>((const u16*)(p.ws + OFF_MG), (const u16*)(p.ws + OFF_WT_O), (u16*)(p.ws + OFF_T1), smem);
  else if (PH == 9) phase_mid(p);
  else if (PH == 10) phase_up(p, smem);
  else if (PH == 11) phase_gemm_f32<DFF, DFF>((const u16*)(p.ws + OFF_ACT), (const u16*)(p.ws + OFF_WT_DOWN), (u16*)(p.ws + OFF_T2), smem);
  else if (PH == 12) phase_final(p);
}

#if MODE_MEGA
#ifndef PROBE_MASK
#define PROBE_MASK 0
#endif
#define XBAR() xcd_barrier((unsigned*)(p.ws + OFF_BAR), smem)
#define RUN(i) _Pragma("nounroll") for (int rep_ = 0; rep_ < ((PROBE_MASK >> i) & 1) + 1; rep_++) { run_phase<i>(p, smem); XBAR(); }
__global__ void __launch_bounds__(512, 2) mega_kernel(Params p) {
  __shared__ __attribute__((aligned(1024))) char smem[SMEM_BYTES];
  cg::grid_group grid = cg::this_grid();
  unsigned* bar = (unsigned*)(p.ws + OFF_BAR);
  volatile LAS unsigned* st = (volatile LAS unsigned*)(smem + SMEM_BYTES - 16);
  if (threadIdx.x == 0) { st[0] = 0u; st[1] = 0u; }
  (void)xcd_barrier_post(bar, st);
  if (p.ws == nullptr) grid.sync();
  RUN(0)
  RUN(1) RUN(2) RUN(3) RUN(4) RUN(5) RUN(6) RUN(7) RUN(8) RUN(9) RUN(10) RUN(11)
  run_phase<12>(p, smem);
}
#else
template <int PH>
__global__ void __launch_bounds__(512, 2) phase_kernel(Params p) {
  __shared__ __attribute__((aligned(1024))) char smem[SMEM_BYTES];
  run_phase<PH>(p, smem);
}
#endif

extern "C" void kernel_launch(void* const* d_in, const int* in_sizes, int n_in, void* d_out, int out_size, void* d_ws,
                              size_t ws_size, hipStream_t stream) {
  Params p{};
  const float** pp = (const float**)&p;
  for (int i = 0; i < 23; i++) pp[i] = (const float*)d_in[i];
  p.out = (float*)d_out;
  p.ws = (unsigned char*)d_ws;
#if MODE_MEGA
  static int grid_blocks = 0;
  if (!grid_blocks) {
    int dev = 0, cus = 0, per_cu = 0;
    hipGetDevice(&dev);
    hipDeviceGetAttribute(&cus, hipDeviceAttributeMultiprocessorCount, dev);
    hipOccupancyMaxActiveBlocksPerMultiprocessor(&per_cu, mega_kernel, 512, 0);
    if (per_cu > 1) per_cu = 1;
    if (per_cu < 1) per_cu = 1;
    grid_blocks = cus * per_cu;
  }
  hipMemsetAsync((unsigned char*)d_ws + OFF_BAR, 0, 16384, stream);
  void* args[] = {&p};
  hipError_t e = hipLaunchCooperativeKernel((void*)mega_kernel, dim3(grid_blocks), dim3(512), args, 0, stream);
  if (e != hipSuccess) fprintf(stderr, "cooperative launch failed: %s (grid %d)\n", hipGetErrorString(e), grid_blocks);
#else
  const int G = 256;
  phase_kernel<0><<<G, 512, 0, stream>>>(p);
  phase_kernel<1><<<G, 512, 0, stream>>>(p);
  phase_kernel<2><<<G, 512, 0, stream>>>(p);
  phase_kernel<3><<<G, 512, 0, stream>>>(p);
  phase_kernel<4><<<G, 512, 0, stream>>>(p);
  phase_kernel<5><<<G, 512, 0, stream>>>(p);
  phase_kernel<6><<<G, 512, 0, stream>>>(p);
  phase_kernel<7><<<G, 512, 0, stream>>>(p);
  phase_kernel<8><<<G, 512, 0, stream>>>(p);
  phase_kernel<9><<<G, 512, 0, stream>>>(p);
  phase_kernel<10><<<G, 512, 0, stream>>>(p);
  phase_kernel<11><<<G, 512, 0, stream>>>(p);
  phase_kernel<12><<<G, 512, 0, stream>>>(p);
#endif
}
```
